# Optimizing an MI355X kernel written in HIP

```python
import math
import jax, jax.numpy as jnp
from jax import lax
import numpy as np

D_MODEL = 2048
BATCH = 1
SEQ = 16384
DEPTH = 1

N_MEM = 256
EPS = 1e-6

DA_HEADS = 8
DA_QK_DIM = 64
DA_V_DIM = 2 * DA_QK_DIM
DA_ROT_DIM = DA_QK_DIM // 4
ROPE_THETA = 500000.0
Q_BLOCK = 128

RET_HEADS = 8
RET_QK_DIM = 64
RET_V_DIM = 128
RET_ROT_BASE = 10000.0
RET_CHUNK = 128

MEM_HEADS = 4
MEM_HEAD_DIM = 256

D_FF = 256 * (-(-(8 * D_MODEL) // (3 * 256)))

DA_Q_W = DA_HEADS * 2 * DA_QK_DIM
DA_K_W = DA_HEADS * 2 * DA_QK_DIM
DA_V_W = DA_HEADS * DA_V_DIM
RET_Q_W = RET_HEADS * RET_QK_DIM
RET_K_W = RET_HEADS * RET_QK_DIM
RET_V_W = RET_HEADS * RET_V_DIM
RET_G_W = RET_HEADS * RET_V_DIM
MEM_W = MEM_HEADS * MEM_HEAD_DIM
N_BRANCH = 3
GATE_W = N_BRANCH * D_MODEL
IN_SIZES = (DA_Q_W, DA_K_W, DA_V_W, RET_Q_W, RET_K_W, RET_V_W, RET_G_W, MEM_W, GATE_W)
IN_COLS = DA_Q_W + DA_K_W + DA_V_W + RET_Q_W + RET_K_W + RET_V_W + RET_G_W + MEM_W + GATE_W

kernel_name = 'hybrid_diffattn_retention_memxattn_swiglu'


def _rms_norm(x, g):
    xf = x.astype(jnp.float32)
    out = xf * lax.rsqrt(jnp.mean(xf * xf, axis=-1, keepdims=True) + EPS)
    return (out * g.astype(jnp.float32)).astype(x.dtype)


def _rope(x, positions, rot_dim, theta):
    half = rot_dim // 2
    inv_freq = theta ** (-jnp.arange(half, dtype=jnp.float32) * 2.0 / rot_dim)
    ang = positions.astype(jnp.float32)[..., None] * inv_freq
    cos = jnp.cos(ang)[:, :, None, :]
    sin = jnp.sin(ang)[:, :, None, :]
    xf = x.astype(jnp.float32)
    x1 = xf[..., :half]
    x2 = xf[..., half:rot_dim]
    out = jnp.concatenate([x1 * cos - x2 * sin, x2 * cos + x1 * sin, xf[..., rot_dim:]], axis=-1)
    return out.astype(x.dtype)


def _split_cols(t, sizes):
    outs, start = [], 0
    for s in sizes:
        outs.append(t[..., start:start + s])
        start += s
    return outs


def _diff_attention(q, k, v, q_g, k_g, lq1, lk1, lq2, lk2, subln_g, positions, lambda_init):
    B, S, _ = q.shape
    H, d, dv = DA_HEADS, DA_QK_DIM, DA_V_DIM
    q = _rms_norm(q.reshape(B, S, H * 2, d), q_g)
    k = _rms_norm(k.reshape(B, S, H * 2, d), k_g)
    q = _rope(q, positions, DA_ROT_DIM, ROPE_THETA).astype(jnp.float32)
    k = _rope(k, positions, DA_ROT_DIM, ROPE_THETA).astype(jnp.float32)
    v = v.reshape(B, S, H, dv).astype(jnp.float32)
    lam = (jnp.exp(jnp.sum(lq1.astype(jnp.float32) * lk1.astype(jnp.float32)))
           - jnp.exp(jnp.sum(lq2.astype(jnp.float32) * lk2.astype(jnp.float32))) + lambda_init)
    scale = d ** -0.5
    nb = S // Q_BLOCK
    qb = q.reshape(B, nb, Q_BLOCK, H, 2, d).transpose(1, 0, 3, 4, 2, 5)
    kh = k.reshape(B, S, H, 2, d).transpose(0, 2, 3, 1, 4)
    vh = v.transpose(0, 2, 1, 3)
    key_pos = jnp.arange(S)

    def attend_block(args):
        q_blk, blk = args
        s = jnp.einsum('bhmqd,bhmkd->bhmqk', q_blk, kh) * scale
        q_pos = blk * Q_BLOCK + jnp.arange(Q_BLOCK)
        causal = key_pos[None, :] <= q_pos[:, None]
        s = jnp.where(causal, s, -jnp.inf)
        p = jax.nn.softmax(s, axis=-1)
        a = p[:, :, 0] - lam * p[:, :, 1]
        return jnp.einsum('bhqk,bhkv->bhqv', a, vh)

    o = lax.map(attend_block, (qb, jnp.arange(nb)))
    o = o.transpose(1, 0, 3, 2, 4).reshape(B, S, H, dv)
    o = _rms_norm(o, subln_g) * (1.0 - lambda_init)
    return o.reshape(B, S, H * dv)


def _retention(q, k, v, g, norm_g, positions):
    B, S, _ = q.shape
    H, dk, dv, C = RET_HEADS, RET_QK_DIM, RET_V_DIM, RET_CHUNK
    q = _rope(q.reshape(B, S, H, dk), positions, dk, RET_ROT_BASE).astype(jnp.float32)
    k = _rope(k.reshape(B, S, H, dk), positions, dk, RET_ROT_BASE).astype(jnp.float32) * (dk ** -0.5)
    v = v.reshape(B, S, H, dv).astype(jnp.float32)
    log_gamma = jnp.log(1.0 - 2.0 ** (-5.0 - jnp.arange(H, dtype=jnp.float32)))
    idx = jnp.arange(C, dtype=jnp.float32)
    rel = idx[:, None] - idx[None, :]
    inner_decay = jnp.where(rel >= 0, jnp.exp(log_gamma[:, None, None] * jnp.maximum(rel, 0.0)), 0.0)
    query_decay = jnp.exp(log_gamma[:, None] * (idx + 1.0))
    key_decay = jnp.exp(log_gamma[:, None] * (C - 1.0 - idx))
    chunk_decay = jnp.exp(log_gamma * C)
    nc = S // C

    def to_chunks(t):
        return t.reshape(B, nc, C, H, t.shape[-1]).transpose(1, 0, 3, 2, 4)

    def step(state, inp):
        qc, kc, vc = inp
        scores = jnp.einsum('bhnd,bhmd->bhnm', qc, kc) * inner_decay
        o_in = jnp.einsum('bhnm,bhmv->bhnv', scores, vc)
        o_cross = jnp.einsum('bhnd,bhdv->bhnv', qc, state) * query_decay[:, :, None]
        state = state * chunk_decay[:, None, None] + jnp.einsum('bhmd,bhmv->bhdv', kc * key_decay[:, :, None], vc)
        return state, o_in + o_cross

    state0 = jnp.zeros((B, H, dk, dv), jnp.float32)
    _, o = lax.scan(step, state0, (to_chunks(q), to_chunks(k), to_chunks(v)))
    o = o.transpose(1, 0, 3, 2, 4).reshape(B, S, H, dv)
    o = _rms_norm(o, norm_g).reshape(B, S, H * dv)
    return jax.nn.silu(g.astype(jnp.float32)) * o


def _memory_attention(q, mem, mem_norm_g, w_mem_kv, q_g, k_g):
    B, S, _ = q.shape
    M = mem.shape[1]
    H, d = MEM_HEADS, MEM_HEAD_DIM
    m = _rms_norm(mem, mem_norm_g)
    kv = m @ w_mem_kv
    k, v = kv[..., :MEM_W], kv[..., MEM_W:]
    q = _rms_norm(q.reshape(B, S, H, d), q_g).astype(jnp.float32)
    k = _rms_norm(k.reshape(B, M, H, d), k_g).astype(jnp.float32)
    v = v.reshape(B, M, H, d).astype(jnp.float32)
    s = jnp.einsum('bshd,bmhd->bhsm', q, k) * (d ** -0.5)
    p = jax.nn.softmax(s, axis=-1)
    o = jnp.einsum('bhsm,bmhd->bshd', p, v)
    return o.reshape(B, S, H * d)


def setup_inputs(seed: int = 0) -> dict:
    key = jax.random.key(seed)
    ks = jax.random.split(key, 32)
    f32 = jnp.float32

    def w(k, shape, fan_in):
        return jax.random.normal(k, shape, f32) * (fan_in ** -0.5)

    def gain(k, shape):
        return 1.0 + 0.02 * jax.random.normal(k, shape, f32)

    L, D = DEPTH, D_MODEL
    return {
        'x': jax.random.normal(ks[0], (BATCH, SEQ, D), f32),
        'mem': jax.random.normal(ks[1], (BATCH, N_MEM, D), f32),
        'positions': jnp.broadcast_to(jnp.arange(SEQ, dtype=jnp.int32)[None, :], (BATCH, SEQ)),
        'attn_norm_g': gain(ks[2], (L, D)),
        'w_in': w(ks[3], (L, D, IN_COLS), D),
        'da_q_norm_g': gain(ks[4], (L, DA_QK_DIM)),
        'da_k_norm_g': gain(ks[5], (L, DA_QK_DIM)),
        'da_lambda_q1': 0.1 * jax.random.normal(ks[6], (L, DA_QK_DIM), f32),
        'da_lambda_k1': 0.1 * jax.random.normal(ks[7], (L, DA_QK_DIM), f32),
        'da_lambda_q2': 0.1 * jax.random.normal(ks[8], (L, DA_QK_DIM), f32),
        'da_lambda_k2': 0.1 * jax.random.normal(ks[9], (L, DA_QK_DIM), f32),
        'da_subln_g': gain(ks[10], (L, DA_V_DIM)),
        'ret_norm_g': gain(ks[11], (L, RET_V_DIM)),
        'mem_norm_g': gain(ks[12], (L, D)),
        'w_mem_kv': w(ks[13], (L, D, 2 * MEM_W), D),
        'mem_q_norm_g': gain(ks[14], (L, MEM_HEAD_DIM)),
        'mem_k_norm_g': gain(ks[15], (L, MEM_HEAD_DIM)),
        'w_o_da': w(ks[16], (L, DA_V_W, D), DA_V_W),
        'w_o_ret': w(ks[17], (L, RET_V_W, D), RET_V_W),
        'w_o_mem': w(ks[18], (L, MEM_W, D), MEM_W),
        'w_out': w(ks[19], (L, D, D), D),
        'ffn_norm_g': gain(ks[20], (L, D)),
        'w_ffn_gate': w(ks[21], (L, D, D_FF), D),
        'w_ffn_up': w(ks[22], (L, D, D_FF), D),
        'w_ffn_down': w(ks[23], (L, D_FF, D), D_FF),
    }


def reference(x, mem, positions, attn_norm_g, w_in, da_q_norm_g, da_k_norm_g,
              da_lambda_q1, da_lambda_k1, da_lambda_q2, da_lambda_k2, da_subln_g,
              ret_norm_g, mem_norm_g, w_mem_kv, mem_q_norm_g, mem_k_norm_g,
              w_o_da, w_o_ret, w_o_mem, w_out, ffn_norm_g, w_ffn_gate, w_ffn_up, w_ffn_down):
    for l in range(DEPTH):
        lambda_init = 0.8 - 0.6 * math.exp(-0.3 * l)
        h = _rms_norm(x, attn_norm_g[l])
        proj = h @ w_in[l]
        da_q, da_k, da_v, r_q, r_k, r_v, r_g, m_q, gates = _split_cols(proj, IN_SIZES)
        o_da = _diff_attention(da_q, da_k, da_v, da_q_norm_g[l], da_k_norm_g[l],
                               da_lambda_q1[l], da_lambda_k1[l], da_lambda_q2[l], da_lambda_k2[l],
                               da_subln_g[l], positions, lambda_init).astype(x.dtype)
        o_ret = _retention(r_q, r_k, r_v, r_g, ret_norm_g[l], positions).astype(x.dtype)
        o_mem = _memory_attention(m_q, mem, mem_norm_g[l], w_mem_kv[l],
                                  mem_q_norm_g[l], mem_k_norm_g[l]).astype(x.dtype)
        g_da, g_ret, g_mem = _split_cols(gates, (D_MODEL, D_MODEL, D_MODEL))
        merged = (jax.nn.sigmoid(g_da) * (o_da @ w_o_da[l])
                  + jax.nn.sigmoid(g_ret) * (o_ret @ w_o_ret[l])
                  + jax.nn.sigmoid(g_mem) * (o_mem @ w_o_mem[l]))
        x = x + merged @ w_out[l]
        hf = _rms_norm(x, ffn_norm_g[l])
        x = x + (jax.nn.silu(hf @ w_ffn_gate[l]) * (hf @ w_ffn_up[l])) @ w_ffn_down[l]
    return x
```

```cpp
#include <hip/hip_runtime.h>
#include <hip/hip_cooperative_groups.h>
#include <cstdio>
#include <cstdint>
namespace cg = cooperative_groups;
#ifndef DUP_P0
#define DUP_P0 1
#endif
#ifndef DUP_P1
#define DUP_P1 1
#endif
#ifndef DUP_P8
#define DUP_P8 1
#endif
#ifndef DUP_P6
#define DUP_P6 1
#endif
#ifndef DUP_R
#define DUP_R 1
#endif

#define LAS __attribute__((address_space(3)))
#define DI __device__ __forceinline__
typedef unsigned short bf16_t;
typedef short bf16x8 __attribute__((ext_vector_type(8)));
typedef float f32x4 __attribute__((ext_vector_type(4)));
typedef float f32x2 __attribute__((ext_vector_type(2)));
typedef float f32x16 __attribute__((ext_vector_type(16)));
typedef unsigned u32x4 __attribute__((ext_vector_type(4)));
typedef unsigned u32x2 __attribute__((ext_vector_type(2)));
typedef __bf16 bf16x2_t __attribute__((ext_vector_type(2)));

DI unsigned pk_bf16(float lo, float hi) { f32x2 v = {lo, hi}; bf16x2_t b = __builtin_convertvector(v, bf16x2_t); return __builtin_bit_cast(unsigned, b); }
DI float bf_lo(unsigned u) { return __uint_as_float(u << 16); }
DI float bf_hi(unsigned u) { return __uint_as_float(u & 0xffff0000u); }
DI float fexp2(float x) { return __builtin_amdgcn_exp2f(x); }
DI float frcp(float x) { return __builtin_amdgcn_rcpf(x); }
DI float frsq(float x) { return __builtin_amdgcn_rsqf(x); }
#define MFMA32(a, b, c) __builtin_amdgcn_mfma_f32_32x32x16_bf16((a), (b), (c), 0, 0, 0)

constexpr int SEQ = 16384, DM = 2048, NCOL = 13312, NG = 6144, DFF = 5632, NMEM = 256;
constexpr float EPS = 1e-6f;
constexpr float LOG2E = 1.4426950408889634f;
constexpr int C_DAQ = 0, C_DAV = 1024, C_RQ = 2048, C_RK = 2560, C_RV = 3072, C_RG = 4096, C_MQ = 5120;
constexpr size_t MiB = 1u << 20;
constexpr size_t WS_PROJ = 0;
constexpr size_t WS_X1B = 0, WS_HMID = 64 * MiB;
constexpr size_t WS_GMEM = 224 * MiB;
constexpr size_t WS_XB = 288 * MiB;
constexpr size_t WS_RETU = 288 * MiB, WS_STATES = 320 * MiB, WS_P = 336 * MiB, WS_VT = 368 * MiB, WS_MERGED = 288 * MiB;
constexpr size_t WS_WIN = 352 * MiB;
constexpr size_t WS_WKV = 404 * MiB, WS_WODA = 412 * MiB, WS_WORET = 416 * MiB, WS_WOMEM = 420 * MiB, WS_WOUT = 424 * MiB;
constexpr size_t WS_WGU = 432 * MiB, WS_WDN = 476 * MiB;
constexpr size_t WS_MISC = 498 * MiB;
constexpr size_t M_RCOS = WS_MISC, M_RSIN = WS_MISC + 2 * MiB, M_DCOS = WS_MISC + 4 * MiB, M_DSIN = WS_MISC + 4 * MiB + 512 * 1024;
constexpr size_t M_RSTDX = WS_MISC + 5 * MiB, M_SUMSQ = M_RSTDX + 65536, M_RQ = M_SUMSQ + 65536, M_LMEM = M_RQ + 262144, M_RSTDM = M_LMEM + 262144;
constexpr size_t M_BAR = M_RSTDM + 65536;
constexpr size_t M_MEMB = WS_MISC + 6 * MiB, M_KVM = WS_MISC + 7 * MiB, M_VTM = WS_MISC + 8 * MiB;
constexpr size_t WS_END = 512 * MiB;

namespace pg8 {
constexpr int BM = 256, BK = 64, HALF = 128, HTB = HALF * BK * 2, STAGE_BYTES = 8 * HTB, NXCD = 8, WGM = 8;
__host__ __device__ __forceinline__ int lds_byte(int r, int c) { const int st = (r >> 4) * 2 + (c >> 5), rr = r & 15, cc = c & 31, ob = rr * 64 + cc * 2; return st * 1024 + (ob ^ (((ob >> 9) & 1) << 5)); }
__host__ __device__ __forceinline__ void stage_rc(int b, int& R, int& C) { const int st = b / 1024, sb = b % 1024, swz = sb ^ (((sb >> 9) & 1) << 5); R = (st >> 1) * 16 + swz / 64; C = (st & 1) * 32 + (swz % 64) / 2; }
__host__ __device__ __forceinline__ int perm32(int rho) { const int n = rho >> 4, i = rho & 15; return 8 * (i >> 2) + 4 * n + (i & 3); }

struct Unit { int pm, pn, aux; };

struct TileSched {
    const char* A; const char* B;
    size_t a_tile_bytes, a_pn_bytes, b_tile_bytes, b_seg_bytes;
    int nM, nN, nwg, G, c, nseg, dup;
    DI void init(int nM_, int nN_, int nseg_, int G_, int c_, int dup_ = 1) { nM = nM_; nN = nN_; nwg = nM * nN; G = G_; c = c_; nseg = nseg_; dup = dup_; }
    DI bool next(int i, Unit& u) const {
        const int ti = i / nseg; u.aux = i - ti * nseg;
        long L = (long)ti * G + c; if (L >= (long)nwg * dup) return false; L %= nwg;
        int wgid = (int)L; { const int q = nwg / NXCD, r = nwg % NXCD, xcd = wgid % NXCD, off = wgid / NXCD; wgid = (xcd < r ? xcd * (q + 1) : r * (q + 1) + (xcd - r) * q) + off; }
        const int nig = WGM * nN, gid = wgid / nig, fm = gid * WGM, gsz = (nM - fm) < WGM ? (nM - fm) : WGM;
        u.pm = fm + ((wgid % nig) % gsz); u.pn = (wgid % nig) / gsz; return true;
    }
    DI const char* pa(const Unit& u) const { const int segcol = (nseg == 3) ? (u.aux == 0 ? C_DAV : (u.aux == 1 ? C_RG : C_MQ)) : 0; return A + (size_t)u.pm * a_tile_bytes + (size_t)u.pn * a_pn_bytes + (size_t)segcol * 2; }
    DI const char* pb(const Unit& u) const { return B + (size_t)u.pn * b_tile_bytes + (size_t)u.aux * b_seg_bytes; }
};

template <class Epi, class Sched>
__device__ __forceinline__ void gemm_phase(LAS unsigned char* lds, const int lda, const int ldb, const int K, const Sched& S, const Epi& E) {
    const int tid = threadIdx.x, wid = __builtin_amdgcn_readfirstlane(tid >> 6), lane = tid & 63, wr = wid >> 2, wc = wid & 3, fr = lane & 15, fq = lane >> 4;
    const int nt = K / BK;
    unsigned voffA[2], voffB[2];
#pragma unroll
    for (int i = 0; i < 2; ++i) { int R, C; stage_rc(tid * 16 + i * 8192, R, C); const int Rb = Epi::PERM ? ((R & ~31) + perm32(R & 31)) : R;
        voffA[i] = (unsigned)(R * lda + C) * 2u; voffB[i] = (unsigned)(Rb * ldb + C) * 2u; }
    const size_t kstep = (size_t)(BK * 2);
    const size_t hstepA = (size_t)HALF * lda * 2, hstepB = (size_t)HALF * ldb * 2;
    const unsigned ldsw = (unsigned)wid * 1024u;
    const int aoff = lds_byte(wr * 64 + fr, fq * 8), boff = lds_byte(wc * 32 + fr, fq * 8);
#define PG8_SA(b, h) (((b) * 2 + (h)) * HTB)
#define PG8_SB(b, h) ((4 + (b) * 2 + (h)) * HTB)
#define PG8_STAGE(bufoff, gbase, voff) do { _Pragma("unroll") for (int _i = 0; _i < 2; ++_i) \
        __builtin_amdgcn_global_load_lds((const unsigned*)((const char*)(gbase) + (voff)[_i]), (LAS unsigned*)(lds + (bufoff) + ldsw + _i * 8192), 16, 0, 0); } while (0)
#define PG8_LDA(dst, b, h) do { _Pragma("unroll") for (int m = 0; m < 4; ++m) _Pragma("unroll") for (int k = 0; k < 2; ++k) dst[m][k] = *(const LAS bf16x8*)(lds + PG8_SA(b, h) + aoff + m * 2048 + k * 1024); } while (0)
#define PG8_LDB(dst, b, h) do { _Pragma("unroll") for (int n = 0; n < 2; ++n) _Pragma("unroll") for (int k = 0; k < 2; ++k) dst[n][k] = *(const LAS bf16x8*)(lds + PG8_SB(b, h) + boff + n * 2048 + k * 1024); } while (0)
#define PG8_MMA(ai, bj, At, Bt) do { __builtin_amdgcn_s_setprio(1); _Pragma("unroll") for (int m = 0; m < 4; ++m) _Pragma("unroll") for (int n = 0; n < 2; ++n) _Pragma("unroll") for (int k = 0; k < 2; ++k) \
        acc[ai][bj][m][n] = __builtin_amdgcn_mfma_f32_16x16x32_bf16(Bt[n][k], At[m][k], acc[ai][bj][m][n], 0, 0, 0); __builtin_amdgcn_s_setprio(0); } while (0)
#define PG8_WAIT_V(n) asm volatile("s_waitcnt vmcnt(" #n ")" ::: "memory")
#define PG8_WAIT_L(n) asm volatile("s_waitcnt lgkmcnt(" #n ")" ::: "memory")
#define PG8_BAR __builtin_amdgcn_s_barrier()
#define PG8_SCHED __builtin_amdgcn_sched_barrier(0)
    Unit cur, nxt; int ui = 0;
    if (!S.next(0, cur)) return;
    f32x4 acc[2][2][4][2];
#pragma unroll
    for (int a = 0; a < 2; ++a)
#pragma unroll
        for (int b = 0; b < 2; ++b)
#pragma unroll
            for (int m = 0; m < 4; ++m)
#pragma unroll
                for (int n = 0; n < 2; ++n) acc[a][b][m][n] = (f32x4){0.f, 0.f, 0.f, 0.f};
    bf16x8 At[4][2], B0[2][2], B1[2][2];
    const char* cA = S.pa(cur); const char* cB = S.pb(cur);
    PG8_STAGE(PG8_SB(0, 0), cB, voffB); PG8_STAGE(PG8_SB(0, 1), cB + hstepB, voffB); PG8_STAGE(PG8_SA(0, 0), cA, voffA); PG8_STAGE(PG8_SA(0, 1), cA + hstepA, voffA);
    if (wr == 1) PG8_BAR;
    PG8_WAIT_V(2); PG8_BAR;
    PG8_STAGE(PG8_SB(1, 0), cB + kstep, voffB); PG8_STAGE(PG8_SA(1, 0), cA + kstep, voffA); PG8_STAGE(PG8_SB(1, 1), cB + hstepB + kstep, voffB);
    PG8_WAIT_V(6); PG8_BAR;
    for (;;) {
        const bool has_next = S.next(ui + 1, nxt);
        const char* nA = has_next ? S.pa(nxt) : cA; const char* nB = has_next ? S.pb(nxt) : cB;
#pragma unroll 1
        for (int t = 0; t < nt; t += 2) {
            const bool last = (t == nt - 2);
            const char* a1 = cA + (size_t)(t + 1) * kstep;
            const char* a2 = last ? nA : cA + (size_t)(t + 2) * kstep; const char* b2 = last ? nB : cB + (size_t)(t + 2) * kstep;
            const char* a3 = a2 + kstep; const char* b3 = b2 + kstep;
            PG8_LDB(B0, 0, 0); PG8_LDB(B1, 0, 1); PG8_SCHED; PG8_LDA(At, 0, 0); PG8_STAGE(PG8_SA(1, 1), a1 + hstepA, voffA);
            PG8_WAIT_V(8); PG8_WAIT_L(0); PG8_BAR; PG8_MMA(0, 0, At, B0); PG8_MMA(0, 1, At, B1); PG8_BAR; PG8_SCHED;
            PG8_LDA(At, 0, 1); PG8_STAGE(PG8_SB(0, 0), b2, voffB); PG8_STAGE(PG8_SB(0, 1), b2 + hstepB, voffB); PG8_STAGE(PG8_SA(0, 0), a2, voffA);
            PG8_WAIT_V(8); PG8_WAIT_L(0); PG8_BAR; PG8_MMA(1, 0, At, B0); PG8_MMA(1, 1, At, B1); PG8_BAR; PG8_SCHED;
            PG8_LDB(B0, 1, 0); PG8_LDB(B1, 1, 1); PG8_SCHED; PG8_LDA(At, 1, 0); PG8_STAGE(PG8_SA(0, 1), a2 + hstepA, voffA);
            PG8_WAIT_V(8); PG8_WAIT_L(0); PG8_BAR; PG8_MMA(0, 0, At, B0); PG8_MMA(0, 1, At, B1); PG8_BAR; PG8_SCHED;
            PG8_LDA(At, 1, 1); PG8_STAGE(PG8_SB(1, 0), b3, voffB); PG8_STAGE(PG8_SB(1, 1), b3 + hstepB, voffB); PG8_STAGE(PG8_SA(1, 0), a3, voffA);
            PG8_WAIT_V(8); PG8_WAIT_L(0); PG8_BAR; PG8_MMA(1, 0, At, B0); PG8_MMA(1, 1, At, B1); PG8_BAR; PG8_SCHED;
        }
        if (wr == 0) PG8_BAR;
        E(acc, cur, wr, wc, fr, fq);
        if (!has_next) break;
        if (!E.keep(cur)) {
#pragma unroll
            for (int a = 0; a < 2; ++a)
#pragma unroll
                for (int b = 0; b < 2; ++b)
#pragma unroll
                    for (int m = 0; m < 4; ++m)
#pragma unroll
                        for (int n = 0; n < 2; ++n) acc[a][b][m][n] = (f32x4){0.f, 0.f, 0.f, 0.f};
        }
        cur = nxt; cA = nA; cB = nB; ++ui;
        if (wr == 1) PG8_BAR;
    }
    PG8_WAIT_V(0);
    PG8_BAR;
#undef PG8_SA
#undef PG8_SB
#undef PG8_STAGE
#undef PG8_LDA
#undef PG8_LDB
#undef PG8_MMA
#undef PG8_WAIT_V
#undef PG8_WAIT_L
#undef PG8_BAR
#undef PG8_SCHED
}
}
using pg8::Unit;
typedef f32x4 Acc[2][2][4][2];

struct EpiRowScale {
    static constexpr bool PERM = true;
    bf16_t* d0; long gdelta; const float* rstd; int mode;
    DI bool keep(const Unit&) const { return false; }
    DI void operator()(Acc& acc, const Unit& u, int wr, int wc, int fr, int fq) const {
        bf16_t* base; int ld, colt;
        if (mode == 1) { base = d0; ld = 2048; colt = u.pn * 256; }
        else if (u.pn < 28) { base = d0; ld = NG; colt = u.pn * 256; }
        else { const int k = (u.pn - 28) >> 3; const long boff = (k < 2) ? (gdelta + (long)k * (long)(64 * MiB)) : (long)(WS_GMEM - WS_PROJ); base = (bf16_t*)((char*)d0 + boff); ld = 2048; colt = ((u.pn - 28) & 7) * 256; }
        const int row0 = u.pm * 256 + wr * 64 + fr, col0 = colt + wc * 32 + 8 * fq;
        float rsv[2][4];
#pragma unroll
        for (int ai = 0; ai < 2; ++ai)
#pragma unroll
            for (int m = 0; m < 4; ++m) rsv[ai][m] = rstd[row0 + ai * 128 + m * 16];
#pragma unroll
        for (int ai = 0; ai < 2; ++ai)
#pragma unroll
            for (int m = 0; m < 4; ++m) { const int row = row0 + ai * 128 + m * 16; const float rs = rsv[ai][m]; bf16_t* rowp = base + (size_t)row * ld + col0;
#pragma unroll
                for (int bj = 0; bj < 2; ++bj) { const f32x4 v0 = acc[ai][bj][m][0] * rs, v1 = acc[ai][bj][m][1] * rs;
                    u32x4 w; w.x = pk_bf16(v0[0], v0[1]); w.y = pk_bf16(v0[2], v0[3]); w.z = pk_bf16(v1[0], v1[1]); w.w = pk_bf16(v1[2], v1[3]);
                    *(u32x4*)(rowp + bj * 128) = w; } }
    }
};
struct EpiInProj {
    static constexpr bool PERM = true;
    unsigned char* wsb; long gdelta; const float* qg; const float* kg;
    DI bool keep(const Unit&) const { return false; }
    DI void operator()(Acc& acc, const Unit& u, int wr, int wc, int fr, int fq) const {
        bf16_t* d0 = (bf16_t*)(wsb + WS_PROJ); bf16_t* kimg = (bf16_t*)(wsb + 192 * MiB); const float* rstd = (const float*)(wsb + M_RSTDX); float* rqsum = (float*)(wsb + M_RQ);
        const float* dcos = (const float*)(wsb + M_DCOS); const float* dsin = (const float*)(wsb + M_DSIN); const float* rcos = (const float*)(wsb + M_RCOS); const float* rsin = (const float*)(wsb + M_RSIN);
        const int row0 = u.pm * 256 + wr * 64 + fr;
        float rsv[2][4];
#pragma unroll
        for (int ai = 0; ai < 2; ++ai)
#pragma unroll
            for (int m = 0; m < 4; ++m) rsv[ai][m] = rstd[row0 + ai * 128 + m * 16];
        if (u.pn < 8) {
            const bool isq = u.pn < 4; const float* gp = isq ? qg : kg;
            const f32x4 g00 = *(const f32x4*)(gp + 8 * fq), g01 = *(const f32x4*)(gp + 8 * fq + 4), g10 = *(const f32x4*)(gp + 32 + 8 * fq), g11 = *(const f32x4*)(gp + 32 + 8 * fq + 4);
            const float osc = isq ? (0.125f * LOG2E) : 1.0f;
            const int grp = (u.pn & 3) * 4 + wc;
#pragma unroll
            for (int ai = 0; ai < 2; ++ai)
#pragma unroll
                for (int m = 0; m < 4; ++m) { const int row = row0 + ai * 128 + m * 16; const float rs = rsv[ai][m];
                    f32x4 a0 = acc[ai][0][m][0] * rs, a1 = acc[ai][0][m][1] * rs, b0 = acc[ai][1][m][0] * rs, b1 = acc[ai][1][m][1] * rs;
                    float ss = 0.f;
#pragma unroll
                    for (int e = 0; e < 4; ++e) ss += a0[e] * a0[e] + a1[e] * a1[e] + b0[e] * b0[e] + b1[e] * b1[e];
                    ss += __shfl_xor(ss, 16); ss += __shfl_xor(ss, 32);
                    const float rn = 1.0f / sqrtf(ss * (1.0f / 64.0f) + EPS);
                    a0 = a0 * rn * g00; a1 = a1 * rn * g01; b0 = b0 * rn * g10; b1 = b1 * rn * g11;
                    { const f32x4 c0 = *(const f32x4*)(dcos + row * 8), c1 = *(const f32x4*)(dcos + row * 8 + 4), s0 = *(const f32x4*)(dsin + row * 8), s1 = *(const f32x4*)(dsin + row * 8 + 4);
                      f32x4 p0, p1;
#pragma unroll
                      for (int e = 0; e < 4; ++e) { p0[e] = __shfl_xor(a0[e], 16); p1[e] = __shfl_xor(a1[e], 16); }
                      if (fq == 0) { a0 = a0 * c0 - p0 * s0; a1 = a1 * c1 - p1 * s1; }
                      else if (fq == 1) { a0 = a0 * c0 + p0 * s0; a1 = a1 * c1 + p1 * s1; } }
                    a0 = a0 * osc; a1 = a1 * osc; b0 = b0 * osc; b1 = b1 * osc;
                    u32x4 wa, wb; wa.x = pk_bf16(a0[0], a0[1]); wa.y = pk_bf16(a0[2], a0[3]); wa.z = pk_bf16(a1[0], a1[1]); wa.w = pk_bf16(a1[2], a1[3]);
                    wb.x = pk_bf16(b0[0], b0[1]); wb.y = pk_bf16(b0[2], b0[3]); wb.z = pk_bf16(b1[0], b1[1]); wb.w = pk_bf16(b1[2], b1[3]);
                    if (isq) { bf16_t* qp = d0 + (size_t)row * NG + C_DAQ + grp * 64 + 8 * fq; *(u32x4*)qp = wa; *(u32x4*)(qp + 32) = wb; }
                    else { const int hd = grp >> 1, mp = grp & 1; bf16_t* kp = kimg + ((((size_t)(hd * 256 + (row >> 6)) * 16 + mp * 8 + fq) * 64 + (row & 63)) * 8);
                        *(u32x4*)kp = wa; *(u32x4*)(kp + 4 * 64 * 8) = wb; } }
            return;
        }
        if (u.pn >= 12 && u.pn < 16) {
            const float osc = (u.pn < 14) ? 1.0f : 0.125f;
            const int grp = (u.pn - 12) * 4 + wc;
#pragma unroll
            for (int ai = 0; ai < 2; ++ai)
#pragma unroll
                for (int m = 0; m < 4; ++m) { const int row = row0 + ai * 128 + m * 16; const float rs = rsv[ai][m];
                    const f32x4 a0 = acc[ai][0][m][0] * rs, a1 = acc[ai][0][m][1] * rs, b0 = acc[ai][1][m][0] * rs, b1 = acc[ai][1][m][1] * rs;
                    const f32x4 c0 = *(const f32x4*)(rcos + row * 32 + 8 * fq), c1 = *(const f32x4*)(rcos + row * 32 + 8 * fq + 4), s0 = *(const f32x4*)(rsin + row * 32 + 8 * fq), s1 = *(const f32x4*)(rsin + row * 32 + 8 * fq + 4);
                    const f32x4 x0 = (a0 * c0 - b0 * s0) * osc, x1 = (a1 * c1 - b1 * s1) * osc, y0 = (b0 * c0 + a0 * s0) * osc, y1 = (b1 * c1 + a1 * s1) * osc;
                    u32x4 wa, wb; wa.x = pk_bf16(x0[0], x0[1]); wa.y = pk_bf16(x0[2], x0[3]); wa.z = pk_bf16(x1[0], x1[1]); wa.w = pk_bf16(x1[2], x1[3]);
                    wb.x = pk_bf16(y0[0], y0[1]); wb.y = pk_bf16(y0[2], y0[3]); wb.z = pk_bf16(y1[0], y1[1]); wb.w = pk_bf16(y1[2], y1[3]);
                    bf16_t* qp = d0 + (size_t)row * NG + C_RQ + grp * 64 + 8 * fq; *(u32x4*)qp = wa; *(u32x4*)(qp + 32) = wb; }
            return;
        }
        bf16_t* base; int ld, colt;
        if (u.pn < 28) { base = d0; ld = NG; colt = (u.pn - 4) * 256; }
        else { const int k = (u.pn - 28) >> 3; const long boff = (k < 2) ? (gdelta + (long)k * (long)(64 * MiB)) : (long)(WS_GMEM - WS_PROJ); base = (bf16_t*)((char*)d0 + boff); ld = 2048; colt = ((u.pn - 28) & 7) * 256; }
        const bool ismq = (u.pn >= 24 && u.pn < 28);
        const int col0 = colt + wc * 32 + 8 * fq;
#pragma unroll
        for (int ai = 0; ai < 2; ++ai)
#pragma unroll
            for (int m = 0; m < 4; ++m) { const int row = row0 + ai * 128 + m * 16; const float rs = rsv[ai][m]; bf16_t* rowp = base + (size_t)row * ld + col0; float ss = 0.f;
#pragma unroll
                for (int bj = 0; bj < 2; ++bj) { const f32x4 v0 = acc[ai][bj][m][0] * rs, v1 = acc[ai][bj][m][1] * rs;
                    u32x4 w; w.x = pk_bf16(v0[0], v0[1]); w.y = pk_bf16(v0[2], v0[3]); w.z = pk_bf16(v1[0], v1[1]); w.w = pk_bf16(v1[2], v1[3]);
                    if (ismq) ss += (bf_lo(w.x) * bf_lo(w.x) + bf_hi(w.x) * bf_hi(w.x)) + (bf_lo(w.y) * bf_lo(w.y) + bf_hi(w.y) * bf_hi(w.y)) + (bf_lo(w.z) * bf_lo(w.z) + bf_hi(w.z) * bf_hi(w.z)) + (bf_lo(w.w) * bf_lo(w.w) + bf_hi(w.w) * bf_hi(w.w));
                    *(u32x4*)(rowp + bj * 128) = w; }
                if (ismq) { ss += __shfl_xor(ss, 16); ss += __shfl_xor(ss, 32); if (fq == 0) atomicAdd(rqsum + row * 4 + (u.pn - 24), ss); } }
    }
};
struct EpiMemS {
    static constexpr bool PERM = true;
    bf16_t* P; const float* rq; float* l;
    DI bool keep(const Unit&) const { return false; }
    DI void operator()(Acc& acc, const Unit& u, int wr, int wc, int fr, int fq) const {
        const int hd = u.pn, row0 = u.pm * 256 + wr * 64 + fr, col0 = hd * 256 + wc * 32 + 8 * fq;
        float rsv[2][4];
#pragma unroll
        for (int ai = 0; ai < 2; ++ai)
#pragma unroll
            for (int m = 0; m < 4; ++m) rsv[ai][m] = 1.0f / sqrtf(rq[(row0 + ai * 128 + m * 16) * 4 + hd] * (1.0f / 256.0f) + EPS);
#pragma unroll
        for (int ai = 0; ai < 2; ++ai)
#pragma unroll
            for (int m = 0; m < 4; ++m) { const int row = row0 + ai * 128 + m * 16; const float rs = rsv[ai][m]; bf16_t* rowp = P + (size_t)row * NG + C_MQ + col0; float sum = 0.f;
#pragma unroll
                for (int bj = 0; bj < 2; ++bj) { f32x4 v0 = acc[ai][bj][m][0] * rs, v1 = acc[ai][bj][m][1] * rs;
#pragma unroll
                    for (int e = 0; e < 4; ++e) { v0[e] = fexp2(v0[e]); v1[e] = fexp2(v1[e]); }
                    u32x4 w; w.x = pk_bf16(v0[0], v0[1]); w.y = pk_bf16(v0[2], v0[3]); w.z = pk_bf16(v1[0], v1[1]); w.w = pk_bf16(v1[2], v1[3]);
                    sum += (bf_lo(w.x) + bf_hi(w.x)) + (bf_lo(w.y) + bf_hi(w.y)) + (bf_lo(w.z) + bf_hi(w.z)) + (bf_lo(w.w) + bf_hi(w.w));
                    *(u32x4*)(rowp + bj * 128) = w; }
                sum += __shfl_xor(sum, 16); sum += __shfl_xor(sum, 32);
                if (fq == 0) atomicAdd(l + row * 4 + hd, sum); }
    }
};
struct EpiMemO {
    static constexpr bool PERM = true;
    bf16_t* O; float* l;
    DI bool keep(const Unit&) const { return false; }
    DI void operator()(Acc& acc, const Unit& u, int wr, int wc, int fr, int fq) const {
        const int hd = u.pn, row0 = u.pm * 256 + wr * 64 + fr, col0 = C_MQ + hd * 256 + wc * 32 + 8 * fq;
        float rsv[2][4];
#pragma unroll
        for (int ai = 0; ai < 2; ++ai)
#pragma unroll
            for (int m = 0; m < 4; ++m) rsv[ai][m] = __hip_atomic_load(l + (row0 + ai * 128 + m * 16) * 4 + hd, __ATOMIC_RELAXED, __HIP_MEMORY_SCOPE_AGENT);
#pragma unroll
        for (int ai = 0; ai < 2; ++ai)
#pragma unroll
            for (int m = 0; m < 4; ++m) { const int row = row0 + ai * 128 + m * 16;
                const float rs = frcp(rsv[ai][m]); bf16_t* rowp = O + (size_t)row * NG + col0;
#pragma unroll
                for (int bj = 0; bj < 2; ++bj) { const f32x4 v0 = acc[ai][bj][m][0] * rs, v1 = acc[ai][bj][m][1] * rs;
                    u32x4 w; w.x = pk_bf16(v0[0], v0[1]); w.y = pk_bf16(v0[2], v0[3]); w.z = pk_bf16(v1[0], v1[1]); w.w = pk_bf16(v1[2], v1[3]);
                    *(u32x4*)(rowp + bj * 128) = w; } }
    }
};
struct EpiMerge {
    static constexpr bool PERM = true;
    const bf16_t* g0; long gmem_delta; bf16_t* out;
    DI bool keep(const Unit& u) const { return u.aux < 2; }
    DI void operator()(Acc& acc, const Unit& u, int wr, int wc, int fr, int fq) const {
        const int seg = u.aux, row0 = u.pm * 256 + wr * 64 + fr, col0 = u.pn * 256 + wc * 32 + 8 * fq;
        const long offs = (seg < 2) ? (long)seg * (long)(64 * MiB) : gmem_delta; const long offn = (seg < 1) ? (long)(64 * MiB) : gmem_delta;
        const bf16_t* gs = (const bf16_t*)((const char*)g0 + offs); const bf16_t* gn = (const bf16_t*)((const char*)g0 + offn);
#pragma unroll
        for (int ai = 0; ai < 2; ++ai) {
            u32x4 ga[4][2], gb[4][2];
#pragma unroll
            for (int m = 0; m < 4; ++m)
#pragma unroll
                for (int bj = 0; bj < 2; ++bj) { const size_t off = (size_t)(row0 + ai * 128 + m * 16) * 2048 + col0 + bj * 128;
                    ga[m][bj] = *(const u32x4*)(gs + off); gb[m][bj] = (seg < 2) ? *(const u32x4*)(gn + off) : ga[m][bj]; }
#pragma unroll
            for (int m = 0; m < 4; ++m) { const size_t off = (size_t)(row0 + ai * 128 + m * 16) * 2048 + col0;
#pragma unroll
                for (int bj = 0; bj < 2; ++bj) {
                    const u32x4 a = ga[m][bj], b = gb[m][bj];
                    float es[8]; es[0] = bf_lo(a.x); es[1] = bf_hi(a.x); es[2] = bf_lo(a.y); es[3] = bf_hi(a.y); es[4] = bf_lo(a.z); es[5] = bf_hi(a.z); es[6] = bf_lo(a.w); es[7] = bf_hi(a.w);
                    float f[8];
                    if (seg < 2) {
                        float en[8]; en[0] = bf_lo(b.x); en[1] = bf_hi(b.x); en[2] = bf_lo(b.y); en[3] = bf_hi(b.y); en[4] = bf_lo(b.z); en[5] = bf_hi(b.z); en[6] = bf_lo(b.w); en[7] = bf_hi(b.w);
#pragma unroll
                        for (int e = 0; e < 8; ++e) f[e] = (1.f + fexp2(-LOG2E * en[e])) * frcp(1.f + fexp2(-LOG2E * es[e]));
                    } else {
#pragma unroll
                        for (int e = 0; e < 8; ++e) f[e] = frcp(1.f + fexp2(-LOG2E * es[e]));
                    }
                    f32x4 v0 = acc[ai][bj][m][0], v1 = acc[ai][bj][m][1];
#pragma unroll
                    for (int e = 0; e < 4; ++e) { v0[e] *= f[e]; v1[e] *= f[4 + e]; }
                    if (seg < 2) { acc[ai][bj][m][0] = v0; acc[ai][bj][m][1] = v1; }
                    else { u32x4 w; w.x = pk_bf16(v0[0], v0[1]); w.y = pk_bf16(v0[2], v0[3]); w.z = pk_bf16(v1[0], v1[1]); w.w = pk_bf16(v1[2], v1[3]);
                        *(u32x4*)(out + off + bj * 128) = w; } } }
        }
    }
};
struct EpiWout {
    static constexpr bool PERM = false;
    const float* x; float* out; bf16_t* x1b; float* sumsq;
    DI bool keep(const Unit&) const { return false; }
    DI void operator()(Acc& acc, const Unit& u, int wr, int wc, int fr, int fq) const {
        const int row0 = u.pm * 256 + wr * 64 + fr, col0 = u.pn * 256 + wc * 32 + 4 * fq;
#pragma unroll
        for (int ai = 0; ai < 2; ++ai) {
            f32x4 xv[4][2][2];
#pragma unroll
            for (int m = 0; m < 4; ++m)
#pragma unroll
                for (int bj = 0; bj < 2; ++bj)
#pragma unroll
                    for (int n = 0; n < 2; ++n) xv[m][bj][n] = *(const f32x4*)(x + (size_t)(row0 + ai * 128 + m * 16) * 2048 + col0 + bj * 128 + n * 16);
#pragma unroll
            for (int m = 0; m < 4; ++m) { const int row = row0 + ai * 128 + m * 16; const size_t off = (size_t)row * 2048 + col0; float ss = 0.f;
#pragma unroll
                for (int bj = 0; bj < 2; ++bj)
#pragma unroll
                    for (int n = 0; n < 2; ++n) { const size_t o = off + bj * 128 + n * 16; const f32x4 v = xv[m][bj][n] + acc[ai][bj][m][n];
                        *(f32x4*)(out + o) = v; ss += (v[0] * v[0] + v[1] * v[1]) + (v[2] * v[2] + v[3] * v[3]);
                        u32x2 w; w.x = pk_bf16(v[0], v[1]); w.y = pk_bf16(v[2], v[3]); *(u32x2*)(x1b + o) = w; }
                ss += __shfl_xor(ss, 16); ss += __shfl_xor(ss, 32);
                if (fq == 0) atomicAdd(sumsq + row, ss); }
        }
    }
};
struct EpiGateUp {
    static constexpr bool PERM = true;
    const float* sumsq; bf16_t* hmid;
    DI bool keep(const Unit&) const { return false; }
    DI void operator()(Acc& acc, const Unit& u, int wr, int wc, int fr, int fq) const {
        const int row0 = u.pm * 256 + wr * 64 + fr, col0 = u.pn * 128 + wc * 32 + 8 * fq;
        float rsv[2][4];
#pragma unroll
        for (int ai = 0; ai < 2; ++ai)
#pragma unroll
            for (int m = 0; m < 4; ++m) rsv[ai][m] = sumsq[row0 + ai * 128 + m * 16];
#pragma unroll
        for (int ai = 0; ai < 2; ++ai)
#pragma unroll
            for (int m = 0; m < 4; ++m) { const int row = row0 + ai * 128 + m * 16; const float rs = frsq(rsv[ai][m] * (1.0f / 2048.0f) + EPS);
                float hv[8];
#pragma unroll
                for (int n = 0; n < 2; ++n)
#pragma unroll
                    for (int e = 0; e < 4; ++e) { const float gg = acc[ai][0][m][n][e] * rs, uu = acc[ai][1][m][n][e] * rs; hv[n * 4 + e] = gg * frcp(1.f + fexp2(-LOG2E * gg)) * uu; }
                u32x4 w; w.x = pk_bf16(hv[0], hv[1]); w.y = pk_bf16(hv[2], hv[3]); w.z = pk_bf16(hv[4], hv[5]); w.w = pk_bf16(hv[6], hv[7]);
                *(u32x4*)(hmid + (size_t)row * DFF + col0) = w; }
    }
};
struct EpiDown {
    static constexpr bool PERM = false;
    float* out;
    DI bool keep(const Unit&) const { return false; }
    DI void operator()(Acc& acc, const Unit& u, int wr, int wc, int fr, int fq) const {
        const int row0 = u.pm * 256 + wr * 64 + fr, col0 = u.pn * 256 + wc * 32 + 4 * fq;
#pragma unroll
        for (int ai = 0; ai < 2; ++ai) {
            f32x4 xv[4][2][2];
#pragma unroll
            for (int m = 0; m < 4; ++m)
#pragma unroll
                for (int bj = 0; bj < 2; ++bj)
#pragma unroll
                    for (int n = 0; n < 2; ++n) xv[m][bj][n] = *(const f32x4*)(out + (size_t)(row0 + ai * 128 + m * 16) * 2048 + col0 + bj * 128 + n * 16);
#pragma unroll
            for (int m = 0; m < 4; ++m)
#pragma unroll
                for (int bj = 0; bj < 2; ++bj)
#pragma unroll
                    for (int n = 0; n < 2; ++n) *(f32x4*)(out + (size_t)(row0 + ai * 128 + m * 16) * 2048 + col0 + bj * 128 + n * 16) = xv[m][bj][n] + acc[ai][bj][m][n];
        }
    }
};

struct Params { const float* in[25]; float* out; unsigned char* ws; int ph_lo, ph_hi; };
enum { I_X = 0, I_MEM, I_POS, I_ANG, I_WIN, I_DQG, I_DKG, I_LQ1, I_LK1, I_LQ2, I_LK2, I_SUBLN, I_RNG, I_MNG, I_WKV, I_MQG, I_MKG, I_WODA, I_WORET, I_WOMEM, I_WOUT, I_FNG, I_WG, I_WU, I_WD };

DI float wave_sum(float v) {
#pragma unroll
    for (int o = 1; o < 64; o <<= 1) v += __shfl_xor(v, o);
    return v;
}

DI void transpose_item(const float* W, int K, int N, const float* g, bf16_t* WT, int rstride, int roff, LAS float* scr, int item, int lane, bool qkperm = false) {
    const int nblk = N / 32, kb = item / nblk, nb = item % nblk, k0 = 64 * kb, n0 = 32 * nb;
    float wv[32];
#pragma unroll
    for (int i = 0; i < 32; ++i) { const int kk = 2 * i + (lane >> 5); wv[i] = W[(size_t)(k0 + kk) * N + n0 + (lane & 31)]; }
    if (g) {
#pragma unroll
        for (int i = 0; i < 32; ++i) wv[i] *= g[k0 + 2 * i + (lane >> 5)];
    }
#pragma unroll
    for (int i = 0; i < 32; ++i) { const int kk = 2 * i + (lane >> 5); scr[kk * 33 + (lane & 31)] = wv[i]; }
    asm volatile("s_waitcnt lgkmcnt(0)" ::: "memory");
    const int c = lane & 7;
#pragma unroll
    for (int j = 0; j < 4; ++j) { const int n = (lane >> 3) + 8 * j; const LAS float* s = scr + (8 * c) * 33 + n;
        u32x4 o; o.x = pk_bf16(s[0 * 33], s[1 * 33]); o.y = pk_bf16(s[2 * 33], s[3 * 33]); o.z = pk_bf16(s[4 * 33], s[5 * 33]); o.w = pk_bf16(s[6 * 33], s[7 * 33]);
        const int ng = n0 + n; int drow = (ng >> 7) * rstride + (ng & 127) + roff;
        if (qkperm && (ng < 2048 || (ng >= 3072 && ng < 4096))) drow = (ng & ~255) + 128 * ((ng >> 5) & 1) + 32 * ((ng >> 6) & 3) + (ng & 31);
        *(u32x4*)(WT + (size_t)drow * K + k0 + 8 * c) = o; }
    asm volatile("s_waitcnt lgkmcnt(0)" ::: "memory");
}
DI void row_to_bf16(const float* xrow, bf16_t* orow, float* rstd_out, int lane) {
    const f32x4* xr = (const f32x4*)xrow + lane; f32x4 v[8]; float s = 0.f;
#pragma unroll
    for (int j = 0; j < 8; ++j) { v[j] = xr[64 * j]; s += (v[j][0] * v[j][0] + v[j][1] * v[j][1]) + (v[j][2] * v[j][2] + v[j][3] * v[j][3]); }
    s = wave_sum(s);
    if (lane == 0) *rstd_out = 1.0f / sqrtf(s * (1.0f / 2048.0f) + EPS);
    u32x2* o8 = (u32x2*)orow + lane;
#pragma unroll
    for (int j = 0; j < 8; ++j) { u32x2 w; w.x = pk_bf16(v[j][0], v[j][1]); w.y = pk_bf16(v[j][2], v[j][3]); o8[64 * j] = w; }
}
DI void tile_transpose64(const bf16_t* src, int lds_, bf16_t* dst, int ldd, int r0, int c0, int dr0, int dc0, LAS bf16_t* T, int tid) {
    { const int r = tid >> 3, ch = tid & 7; const u32x4 v = *(const u32x4*)(src + (size_t)(r0 + r) * lds_ + c0 + ch * 8);
      LAS bf16_t* t = T + (ch * 8) * 72 + r;
      t[0 * 72] = (bf16_t)(v.x & 0xffff); t[1 * 72] = (bf16_t)(v.x >> 16); t[2 * 72] = (bf16_t)(v.y & 0xffff); t[3 * 72] = (bf16_t)(v.y >> 16);
      t[4 * 72] = (bf16_t)(v.z & 0xffff); t[5 * 72] = (bf16_t)(v.z >> 16); t[6 * 72] = (bf16_t)(v.w & 0xffff); t[7 * 72] = (bf16_t)(v.w >> 16); }
    __syncthreads();
    { const int c = tid >> 3, ch = tid & 7; const u32x4 v = *(const LAS u32x4*)(T + c * 72 + ch * 8);
      *(u32x4*)(dst + (size_t)(dr0 + c) * ldd + dc0 + ch * 8) = v; }
    __syncthreads();
}

DI int lane_id() { return (int)__builtin_amdgcn_mbcnt_hi(~0u, __builtin_amdgcn_mbcnt_lo(~0u, 0u)); }
DI int pi32(int r) { return (r & ~12) | ((r & 4) << 1) | ((r & 8) >> 1); }

template <bool MASK>
DI void da_tile(const LAS unsigned char* Kb, const LAS unsigned char* Vb, const LAS unsigned char* Qb, f32x16 (&o1)[4], f32x16 (&o2)[4], float& l1, float& l2, int qrel, int khmax) {
#pragma unroll
    for (int kh = 0; kh < 2; ++kh) {
        if (!MASK || kh <= khmax) {
        bf16x8 pf1[2], pf2[2];
#pragma unroll
        for (int m = 0; m < 2; ++m) {
            f32x16 sv = f32x16{};
#pragma unroll
            for (int kp = 0; kp < 2; ++kp) {
                bf16x8 kf[2], qf[2];
#pragma unroll
                for (int k2 = 0; k2 < 2; ++k2) { const int ks = 2 * kp + k2; kf[k2] = *(const LAS bf16x8*)(Kb + (8 * m + 2 * ks) * 1024 + kh * 512); qf[k2] = *(const LAS bf16x8*)(Qb + (8 * m + 2 * ks) * 512); }
#pragma unroll
                for (int k2 = 0; k2 < 2; ++k2) sv = MFMA32(kf[k2], qf[k2], sv);
            }
            __builtin_amdgcn_sched_barrier(0);
            float ls = 0.f;
#pragma unroll
            for (int i = 0; i < 16; ++i) { float pv = fexp2(sv[i]);
                if (MASK) { const int key = 32 * kh + 16 * (i >> 3) + (i & 7); pv = (key > qrel) ? 0.f : pv; }
                sv[i] = pv; ls += pv; }
            if (m == 0) l1 += ls; else l2 += ls;
#pragma unroll
            for (int sx = 0; sx < 2; ++sx) { u32x4 w;
                w.x = pk_bf16(sv[8 * sx + 0], sv[8 * sx + 1]); w.y = pk_bf16(sv[8 * sx + 2], sv[8 * sx + 3]); w.z = pk_bf16(sv[8 * sx + 4], sv[8 * sx + 5]); w.w = pk_bf16(sv[8 * sx + 6], sv[8 * sx + 7]);
                if (m == 0) pf1[sx] = __builtin_bit_cast(bf16x8, w); else pf2[sx] = __builtin_bit_cast(bf16x8, w); }
        }
#pragma unroll
        for (int dp = 0; dp < 2; ++dp) {
            bf16x8 vf[2][2];
#pragma unroll
            for (int d2 = 0; d2 < 2; ++d2)
#pragma unroll
                for (int sx = 0; sx < 2; ++sx) vf[d2][sx] = *(const LAS bf16x8*)(Vb + (4 * kh + 2 * sx) * 2048 + (2 * dp + d2) * 512);
#pragma unroll
            for (int d2 = 0; d2 < 2; ++d2)
#pragma unroll
                for (int sx = 0; sx < 2; ++sx) { o1[2 * dp + d2] = MFMA32(vf[d2][sx], pf1[sx], o1[2 * dp + d2]); o2[2 * dp + d2] = MFMA32(vf[d2][sx], pf2[sx], o2[2 * dp + d2]); }
            __builtin_amdgcn_sched_barrier(0);
        }
        }
    }
}

DI void da_unit(LAS unsigned char* lds, bf16_t* projng, const bf16_t* kimg, const bf16_t* vimg, const float* subln, int head, int qb, float lam) {
    const int tid = threadIdx.x, lane = lane_id(), r = lane & 31, h = lane >> 5; const int wid = __builtin_amdgcn_readfirstlane(tid >> 6);
    const int qw = qb * 256 + wid * 32, NT = 4 * (qb + 1);
    f32x16 o1[4], o2[4];
#pragma unroll
    for (int d = 0; d < 4; ++d) { o1[d] = f32x16{}; o2[d] = f32x16{}; }
    float l1 = 0.f, l2 = 0.f;
    const bf16_t* ksrc = kimg + (size_t)head * 256 * 8192 + (2 * wid) * 512 + lane * 8;
    const bf16_t* vsrc = vimg + (size_t)head * 256 * 8192 + wid * 1024 + lane * 8;
    LAS unsigned char* kdst = lds + (2 * wid) * 1024; LAS unsigned char* vdst = lds + 32768 + wid * 2048;
#define DA_DMA(t, buf) do { \
        __builtin_amdgcn_global_load_lds((const unsigned*)(ksrc + (size_t)(t) * 8192), (LAS unsigned*)(kdst + (buf) * 16384), 16, 0, 0); \
        __builtin_amdgcn_global_load_lds((const unsigned*)(ksrc + (size_t)(t) * 8192 + 512), (LAS unsigned*)(kdst + (buf) * 16384 + 1024), 16, 0, 0); \
        __builtin_amdgcn_global_load_lds((const unsigned*)(vsrc + (size_t)(t) * 8192), (LAS unsigned*)(vdst + (buf) * 16384), 16, 0, 0); \
        __builtin_amdgcn_global_load_lds((const unsigned*)(vsrc + (size_t)(t) * 8192 + 512), (LAS unsigned*)(vdst + (buf) * 16384 + 1024), 16, 0, 0); } while (0)
    { const bf16_t* qsrc = projng + (size_t)(qw + r) * NG + C_DAQ + head * 128 + h * 8; LAS unsigned char* qdst = lds + 65536 + wid * 8192;
#pragma unroll
      for (int j = 0; j < 8; ++j) __builtin_amdgcn_global_load_lds((const unsigned*)(qsrc + j * 16), (LAS unsigned*)(qdst + j * 1024), 16, 0, 0); }
    const int kbase = h * 1024 + pi32(r) * 16;
    const int vbase = h * 2048 + r * 16;
    const LAS unsigned char* Qb = lds + 65536 + wid * 8192 + h * 512 + r * 16;
    DA_DMA(0, 0);
    __syncthreads();
    if (wid >= 4) __builtin_amdgcn_s_setprio(1);
    const int n_full = (qw + 1) >> 6;
    for (int t = 0; t < n_full; ++t) {
        const int buf = t & 1;
        DA_DMA(t + 1, buf ^ 1);
        da_tile<false>(lds + buf * 16384 + kbase, lds + 32768 + buf * 16384 + vbase, Qb, o1, o2, l1, l2, 0, 1);
        __syncthreads();
    }
    for (int t = n_full; t < NT; ++t) {
        const int buf = t & 1;
        if (t + 1 < NT) DA_DMA(t + 1, buf ^ 1);
        if (64 * t <= qw + 31) da_tile<true>(lds + buf * 16384 + kbase, lds + 32768 + buf * 16384 + vbase, Qb, o1, o2, l1, l2, qw + r - 64 * t - 8 * h, (64 * t + 32 > qw + 31) ? 0 : 1);
        __syncthreads();
    }
#undef DA_DMA
    __builtin_amdgcn_s_setprio(0);
    l1 += __shfl_xor(l1, 32); l2 += __shfl_xor(l2, 32);
    const float i1 = 1.0f / l1, i2 = lam / l2; float ss = 0.f;
#pragma unroll
    for (int db = 0; db < 4; ++db)
#pragma unroll
        for (int i = 0; i < 16; ++i) { const float v = o1[db][i] * i1 - o2[db][i] * i2; o1[db][i] = v; ss += v * v; }
    ss += __shfl_xor(ss, 32);
    const float rs = 0.8f / sqrtf(ss * (1.0f / 128.0f) + EPS);
    bf16_t* orow = projng + (size_t)(qw + r) * NG + C_DAV + head * 128 + 4 * h;
#pragma unroll
    for (int db = 0; db < 4; ++db)
#pragma unroll
        for (int g4 = 0; g4 < 4; ++g4) { const int dv = 32 * db + 8 * g4; const f32x4 gv = *(const f32x4*)(subln + dv + 4 * h);
            u32x2 w; w.x = pk_bf16(o1[db][4 * g4 + 0] * rs * gv[0], o1[db][4 * g4 + 1] * rs * gv[1]); w.y = pk_bf16(o1[db][4 * g4 + 2] * rs * gv[2], o1[db][4 * g4 + 3] * rs * gv[3]);
            *(u32x2*)(orow + dv) = w; }
}

DI void ret_load_vt(LAS bf16_t* VTs, const bf16_t* projng, int pos0, int hd, int tid) {
#pragma unroll
    for (int i = 0; i < 4; ++i) { const int id = tid + 512 * i, pos = id >> 4, ch = id & 15;
        const u32x4 v = *(const u32x4*)(projng + (size_t)(pos0 + pos) * NG + C_RV + hd * 128 + ch * 8);
        LAS bf16_t* t = VTs + (ch * 8) * 136 + pos;
        t[0 * 136] = (bf16_t)(v.x & 0xffff); t[1 * 136] = (bf16_t)(v.x >> 16); t[2 * 136] = (bf16_t)(v.y & 0xffff); t[3 * 136] = (bf16_t)(v.y >> 16);
        t[4 * 136] = (bf16_t)(v.z & 0xffff); t[5 * 136] = (bf16_t)(v.z >> 16); t[6 * 136] = (bf16_t)(v.w & 0xffff); t[7 * 136] = (bf16_t)(v.w >> 16); }
}
DI void ret_r1_unit(LAS unsigned char* lds, const bf16_t* projng, float* retU, int c, int hd) {
    const int tid = threadIdx.x, lane = lane_id(), r = lane & 31, h = lane >> 5; const int wid = __builtin_amdgcn_readfirstlane(tid >> 6);
    LAS bf16_t* VTs = (LAS bf16_t*)lds; LAS bf16_t* KTs = (LAS bf16_t*)(lds + 128 * 272);
    const int pos0 = c * 128; const float lg = log2f(1.0f - exp2f(-5.0f - (float)hd));
    ret_load_vt(VTs, projng, pos0, hd, tid);
#pragma unroll
    for (int i = 0; i < 2; ++i) { const int id = tid + 512 * i, pos = id >> 3, ch = id & 7;
        const u32x4 v = *(const u32x4*)(projng + (size_t)(pos0 + pos) * NG + C_RK + hd * 64 + ch * 8);
        const float kd = fexp2(lg * (float)(127 - pos));
        LAS bf16_t* t = KTs + (ch * 8) * 136 + pos;
        t[0 * 136] = (bf16_t)(pk_bf16(bf_lo(v.x) * kd, 0.f) & 0xffff); t[1 * 136] = (bf16_t)(pk_bf16(bf_hi(v.x) * kd, 0.f) & 0xffff);
        t[2 * 136] = (bf16_t)(pk_bf16(bf_lo(v.y) * kd, 0.f) & 0xffff); t[3 * 136] = (bf16_t)(pk_bf16(bf_hi(v.y) * kd, 0.f) & 0xffff);
        t[4 * 136] = (bf16_t)(pk_bf16(bf_lo(v.z) * kd, 0.f) & 0xffff); t[5 * 136] = (bf16_t)(pk_bf16(bf_hi(v.z) * kd, 0.f) & 0xffff);
        t[6 * 136] = (bf16_t)(pk_bf16(bf_lo(v.w) * kd, 0.f) & 0xffff); t[7 * 136] = (bf16_t)(pk_bf16(bf_hi(v.w) * kd, 0.f) & 0xffff); }
    __syncthreads();
    const int db = wid >> 1, nb = wid & 1; f32x16 acc = f32x16{};
#pragma unroll
    for (int ks = 0; ks < 8; ++ks) { const bf16x8 a = *(const LAS bf16x8*)(VTs + (32 * db + r) * 136 + 16 * ks + 8 * h); const bf16x8 b = *(const LAS bf16x8*)(KTs + (32 * nb + r) * 136 + 16 * ks + 8 * h);
        acc = MFMA32(a, b, acc); }
    float* up = retU + ((size_t)(c * 8 + hd) * 128 + 32 * db + 4 * h) * 64 + 32 * nb + r;
#pragma unroll
    for (int i = 0; i < 16; ++i) up[((i & 3) + 8 * (i >> 2)) * 64] = acc[i];
    __syncthreads();
}
DI void ret_r3_unit(LAS unsigned char* lds, bf16_t* projng, const bf16_t* states, const float* norm_g, int c, int hd) {
    const int tid = threadIdx.x, lane = lane_id(), r = lane & 31, h = lane >> 5; const int wid = __builtin_amdgcn_readfirstlane(tid >> 6);
    LAS bf16_t* VTs = (LAS bf16_t*)lds; LAS bf16_t* Ks = (LAS bf16_t*)(lds + 128 * 272); LAS float* red = (LAS float*)(lds + 128 * 272 + 128 * 144);
    const int pos0 = c * 128; const float lg = log2f(1.0f - exp2f(-5.0f - (float)hd));
    ret_load_vt(VTs, projng, pos0, hd, tid);
#pragma unroll
    for (int i = 0; i < 2; ++i) { const int id = tid + 512 * i, pos = id >> 3, ch = id & 7;
        const u32x4 v = *(const u32x4*)(projng + (size_t)(pos0 + pos) * NG + C_RK + hd * 64 + ch * 8);
        *(LAS u32x4*)(Ks + pos * 72 + ch * 8) = v; }
    const int qb = wid & 3, dh = wid >> 2, n = 32 * qb + r;
    bf16x8 qf[4];
    { const bf16_t* qrow = projng + (size_t)(pos0 + n) * NG + C_RQ + hd * 64 + 8 * h;
#pragma unroll
      for (int ks = 0; ks < 4; ++ks) qf[ks] = *(const bf16x8*)(qrow + 16 * ks); }
    f32x16 o[2];
    { const float qd = fexp2(lg * (float)(n + 1));
#pragma unroll
      for (int d2 = 0; d2 < 2; ++d2) { o[d2] = f32x16{}; const bf16_t* sp = states + ((size_t)(c * 8 + hd) * 128 + 32 * (2 * dh + d2) + r) * 64 + 8 * h;
#pragma unroll
          for (int ks = 0; ks < 4; ++ks) { const bf16x8 a = *(const bf16x8*)(sp + 16 * ks); o[d2] = MFMA32(a, qf[ks], o[d2]); }
#pragma unroll
          for (int i = 0; i < 16; ++i) o[d2][i] *= qd; } }
    __syncthreads();
    const int pr = pi32(r);
    for (int kb = 0; kb <= qb; ++kb) {
        f32x16 s = f32x16{};
#pragma unroll
        for (int ks = 0; ks < 4; ++ks) { const bf16x8 a = *(const LAS bf16x8*)(Ks + (32 * kb + pr) * 72 + 16 * ks + 8 * h); s = MFMA32(a, qf[ks], s); }
        bf16x8 pf[2];
#pragma unroll
        for (int i = 0; i < 16; ++i) { const int mk = 32 * kb + 16 * (i >> 3) + 8 * h + (i & 7); const int dlt = n - mk; s[i] = (dlt >= 0) ? s[i] * fexp2(lg * (float)dlt) : 0.f; }
#pragma unroll
        for (int sx = 0; sx < 2; ++sx) { u32x4 w; w.x = pk_bf16(s[8 * sx + 0], s[8 * sx + 1]); w.y = pk_bf16(s[8 * sx + 2], s[8 * sx + 3]); w.z = pk_bf16(s[8 * sx + 4], s[8 * sx + 5]); w.w = pk_bf16(s[8 * sx + 6], s[8 * sx + 7]);
            pf[sx] = __builtin_bit_cast(bf16x8, w); }
#pragma unroll
        for (int d2 = 0; d2 < 2; ++d2)
#pragma unroll
            for (int sx = 0; sx < 2; ++sx) { const bf16x8 a = *(const LAS bf16x8*)(VTs + (32 * (2 * dh + d2) + r) * 136 + 32 * kb + 16 * sx + 8 * h); o[d2] = MFMA32(a, pf[sx], o[d2]); }
    }
    float ss = 0.f;
#pragma unroll
    for (int d2 = 0; d2 < 2; ++d2)
#pragma unroll
        for (int i = 0; i < 16; ++i) ss += o[d2][i] * o[d2][i];
    ss += __shfl_xor(ss, 32);
    if (h == 0) red[wid * 32 + r] = ss;
    __syncthreads();
    const float tot = red[wid * 32 + r] + red[(wid ^ 4) * 32 + r];
    const float rs = 1.0f / sqrtf(tot * (1.0f / 128.0f) + EPS);
    bf16_t* grow = projng + (size_t)(pos0 + n) * NG + C_RG + hd * 128 + 4 * h;
#pragma unroll
    for (int d2 = 0; d2 < 2; ++d2)
#pragma unroll
        for (int g4 = 0; g4 < 4; ++g4) { const int dv = 32 * (2 * dh + d2) + 8 * g4; const f32x4 gv = *(const f32x4*)(norm_g + dv + 4 * h); const u32x2 gt = *(const u32x2*)(grow + dv);
            float ga[4] = {bf_lo(gt.x), bf_hi(gt.x), bf_lo(gt.y), bf_hi(gt.y)}; float y[4];
#pragma unroll
            for (int e = 0; e < 4; ++e) { const float sl = ga[e] * frcp(1.f + fexp2(-LOG2E * ga[e])); y[e] = o[d2][4 * g4 + e] * rs * gv[e] * sl; }
            u32x2 w; w.x = pk_bf16(y[0], y[1]); w.y = pk_bf16(y[2], y[3]); *(u32x2*)(grow + dv) = w; }
    __syncthreads();
}

#define XB_XCNT(j) (64 * (j))
#define XB_XSUB(j) (1024 + 64 * (j))
#define XB_XGEN(j) (2048 + 64 * (j))
#define XB_TOP 3072
#define XB_TOPGEN 3136
#define XB_WORDS 3200
DI unsigned xb_ld(unsigned* p) { return __hip_atomic_load(p, __ATOMIC_RELAXED, __HIP_MEMORY_SCOPE_AGENT); }
DI unsigned xb_add(unsigned* p, unsigned v) { return __hip_atomic_fetch_add(p, v, __ATOMIC_RELAXED, __HIP_MEMORY_SCOPE_AGENT); }
DI unsigned xb_xcc_id() { return (unsigned)__builtin_amdgcn_s_getreg((3 << 11) | 20) & 0xFu; }
DI void grid_bar(unsigned* bar, unsigned G, volatile LAS unsigned* st) {
    asm volatile("s_waitcnt vmcnt(0) lgkmcnt(0)" ::: "memory");
    __syncthreads();
    if (threadIdx.x == 0) {
        const unsigned x = xb_xcc_id();
        unsigned nloc = st[0], nx = st[1];
        if (nloc == 0u) {
            for (;;) { unsigned sum = 0u, cnt = 0u, mine = 0u;
#pragma unroll
                for (unsigned j = 0; j < 16; ++j) { const unsigned c = xb_ld(&bar[XB_XCNT(j)]); sum += c; cnt += (c > 0u) ? 1u : 0u; mine = (j == x) ? c : mine; }
                if (sum == G) { nloc = mine; nx = cnt; break; }
                __builtin_amdgcn_s_sleep(2); }
            st[0] = nloc; st[1] = nx; }
        const unsigned old = xb_add(&bar[XB_XSUB(x)], 1u);
        const unsigned gen = old / nloc;
        if (old + 1u == (gen + 1u) * nloc) {
            __builtin_amdgcn_fence(__ATOMIC_RELEASE, "agent");
            asm volatile("s_waitcnt vmcnt(0)" ::: "memory");
            const unsigned og = xb_add(&bar[XB_TOP], 1u);
            const unsigned tg = og / nx;
            if (og + 1u == (tg + 1u) * nx) xb_add(&bar[XB_TOPGEN], 1u);
            else while (xb_ld(&bar[XB_TOPGEN]) == tg) __builtin_amdgcn_s_sleep(1);
            __builtin_amdgcn_fence(__ATOMIC_ACQUIRE, "agent");
            xb_add(&bar[XB_XGEN(x)], 1u);
            asm volatile("s_waitcnt vmcnt(0)" ::: "memory");
        } else {
            while (xb_ld(&bar[XB_XGEN(x)]) == gen) __builtin_amdgcn_s_sleep(1);
            __builtin_amdgcn_fence(__ATOMIC_ACQUIRE, "agent");
            asm volatile("s_waitcnt vmcnt(0)" ::: "memory");
        }
    }
    __syncthreads();
}

constexpr int LDS_BYTES = 147456;
__global__ void __launch_bounds__(512, 2) mega(Params p) {
    extern __shared__ __attribute__((aligned(16))) unsigned char lds_raw[];
    LAS unsigned char* lds = (LAS unsigned char*)lds_raw;
    cg::grid_group grid = cg::this_grid();
    const int tid = threadIdx.x, lane = tid & 63; const int wave = __builtin_amdgcn_readfirstlane(tid >> 6);
    const int G = gridDim.x, bid = blockIdx.x;
    const int gw = bid * 8 + wave, NGW = G * 8;
    unsigned char* ws = p.ws;
    bf16_t* projng = (bf16_t*)(ws + WS_PROJ);
    bf16_t* gda = (bf16_t*)p.out; bf16_t* gret = (bf16_t*)((unsigned char*)p.out + 64 * MiB); bf16_t* gmem = (bf16_t*)(ws + WS_GMEM);
    bf16_t* xb = (bf16_t*)(ws + WS_XB);
    bf16_t* win_t = (bf16_t*)(ws + WS_WIN); bf16_t* wkv_t = (bf16_t*)(ws + WS_WKV);
    bf16_t* woda_t = (bf16_t*)(ws + WS_WODA); bf16_t* woret_t = (bf16_t*)(ws + WS_WORET); bf16_t* womem_t = (bf16_t*)(ws + WS_WOMEM); bf16_t* wout_t = (bf16_t*)(ws + WS_WOUT);
    bf16_t* wgu_t = (bf16_t*)(ws + WS_WGU); bf16_t* wdn_t = (bf16_t*)(ws + WS_WDN);
    float* rcos = (float*)(ws + M_RCOS); float* rsin = (float*)(ws + M_RSIN); float* dcos = (float*)(ws + M_DCOS); float* dsin = (float*)(ws + M_DSIN);
    float* rstdx = (float*)(ws + M_RSTDX); float* sumsq = (float*)(ws + M_SUMSQ); float* rq = (float*)(ws + M_RQ); float* lmem = (float*)(ws + M_LMEM); float* rstdm = (float*)(ws + M_RSTDM);
    bf16_t* memb = (bf16_t*)(ws + M_MEMB); bf16_t* kvm = (bf16_t*)(ws + M_KVM); bf16_t* vtm = (bf16_t*)(ws + M_VTM);
    float* retU = (float*)(ws + WS_RETU); bf16_t* states = (bf16_t*)(ws + WS_STATES); bf16_t* kimg = (bf16_t*)(ws + 192 * MiB);     bf16_t* vimg = (bf16_t*)(ws + WS_VT);
    bf16_t* merged = (bf16_t*)(ws + WS_MERGED); bf16_t* x1b = (bf16_t*)(ws + WS_X1B); bf16_t* hmid = (bf16_t*)(ws + WS_HMID);
    unsigned* barw = (unsigned*)(ws + M_BAR);
    volatile LAS unsigned* bst = (volatile LAS unsigned*)(lds + 131072 + 256);
    if (tid == 0) { bst[0] = 0u; bst[1] = 0u; }
    __syncthreads();
    const int lo = p.ph_lo, hi = p.ph_hi;
#ifndef PHASE_MASK
#define PHASE_MASK 0x3ff
#endif
#define IN(k) (((PHASE_MASK >> (k)) & 1) && lo <= (k) && (k) < hi)
#define SEAM(k) do { if (IN(k) && IN((k) + 1)) { if ((k) == 0) grid.sync(); else grid_bar(barw, (unsigned)G, bst); } } while (0)

    if (IN(0)) {
        LAS float* scr = (LAS float*)(lds + wave * 16384);
        const int I_WIN_N = 32 * (NCOL / 32), I_KV_N = 32 * 64, I_O_N = 16 * 64, I_OUT_N = 32 * 64, I_G_N = 32 * (DFF / 32), I_D_N = (DFF / 64) * 64;
        const int NITEMS = I_WIN_N + I_KV_N + 3 * I_O_N + I_OUT_N + 2 * I_G_N + I_D_N;
        for (int it = gw; it < NITEMS * DUP_P0; it += NGW) {
            int r = it % NITEMS;
            if (r < I_WIN_N) { transpose_item(p.in[I_WIN], DM, NCOL, p.in[I_ANG], win_t, 128, 0, scr, r, lane, true); continue; } r -= I_WIN_N;
            if (r < I_KV_N) { transpose_item(p.in[I_WKV], DM, 2048, p.in[I_MNG], wkv_t, 128, 0, scr, r, lane); continue; } r -= I_KV_N;
            if (r < I_O_N) { transpose_item(p.in[I_WODA], 1024, DM, nullptr, woda_t, 128, 0, scr, r, lane); continue; } r -= I_O_N;
            if (r < I_O_N) { transpose_item(p.in[I_WORET], 1024, DM, nullptr, woret_t, 128, 0, scr, r, lane); continue; } r -= I_O_N;
            if (r < I_O_N) { transpose_item(p.in[I_WOMEM], 1024, DM, nullptr, womem_t, 128, 0, scr, r, lane); continue; } r -= I_O_N;
            if (r < I_OUT_N) { transpose_item(p.in[I_WOUT], DM, DM, nullptr, wout_t, 128, 0, scr, r, lane); continue; } r -= I_OUT_N;
            if (r < I_G_N) { transpose_item(p.in[I_WG], DM, DFF, p.in[I_FNG], wgu_t, 256, 0, scr, r, lane); continue; } r -= I_G_N;
            if (r < I_G_N) { transpose_item(p.in[I_WU], DM, DFF, p.in[I_FNG], wgu_t, 256, 128, scr, r, lane); continue; } r -= I_G_N;
            transpose_item(p.in[I_WD], DFF, DM, nullptr, wdn_t, 128, 0, scr, r, lane);
        }
        for (int m = gw; m < SEQ; m += NGW) row_to_bf16(p.in[I_X] + (size_t)m * DM, xb + (size_t)m * DM, rstdx + m, lane);
        for (int m = gw; m < NMEM; m += NGW) row_to_bf16(p.in[I_MEM] + (size_t)m * DM, memb + (size_t)m * DM, rstdm + m, lane);
        const int* posi = (const int*)p.in[I_POS];
        for (int i = bid * 512 + tid; i < SEQ * 40; i += G * 512) {
            const int row = i / 40, j = i - row * 40; const double pos = (double)posi[row];
            double inv; if (j < 32) inv = exp(-((double)j / 32.0) * 9.210340371976184); else inv = exp(-((double)(j - 32) / 8.0) * 13.122363377404328);
            const double turns = pos * inv * 0.15915494309189535; const float fr_ = (float)(turns - rint(turns));
            const float cs = __builtin_amdgcn_cosf(fr_), sn = __builtin_amdgcn_sinf(fr_);
            if (j < 32) { rcos[row * 32 + j] = cs; rsin[row * 32 + j] = sn; } else { dcos[row * 8 + j - 32] = cs; dsin[row * 8 + j - 32] = sn; }
        }
        if (bid == 0) for (int i = tid; i < XB_WORDS; i += 512) barw[i] = 0u;
        for (int i = bid * 512 + tid; i < SEQ; i += G * 512) sumsq[i] = 0.f;
        for (int i = bid * 512 + tid; i < SEQ * 4; i += G * 512) { lmem[i] = 0.f; rq[i] = 0.f; }
    }
    SEAM(0);
    if (IN(1)) {
        if (tid == 0) (void)xb_add(&barw[XB_XCNT(xb_xcc_id())], 1u);
        { pg8::TileSched S; S.init(SEQ / 256, NCOL / 256, 1, G, bid, DUP_P1); S.A = (const char*)xb; S.B = (const char*)win_t; S.a_tile_bytes = (size_t)256 * DM * 2; S.a_pn_bytes = 0; S.b_seg_bytes = 0; S.b_tile_bytes = (size_t)256 * DM * 2;
          EpiInProj E{ws, (long)((char*)p.out - (char*)projng), p.in[I_DQG], p.in[I_DKG]};
          pg8::gemm_phase<EpiInProj, pg8::TileSched>(lds, DM, DM, DM, S, E); }
    }
    SEAM(1);
    if (IN(2)) {
        const bool kvblk = (G > 16) && (bid < 8);
        const int eb = (G > 16) ? bid - 8 : bid, EG = (G > 16) ? G - 8 : G;
        if (kvblk || G <= 16) {
          pg8::TileSched S; S.init(1, 8, 1, (G > 16) ? 8 : G, bid); S.A = (const char*)memb; S.B = (const char*)wkv_t; S.a_tile_bytes = (size_t)256 * DM * 2; S.a_pn_bytes = 0; S.b_seg_bytes = 0; S.b_tile_bytes = (size_t)256 * DM * 2;
          EpiRowScale E{kvm, 0, rstdm, 1};
          pg8::gemm_phase<EpiRowScale, pg8::TileSched>(lds, DM, DM, DM, S, E); }
        if (!kvblk) {
        { LAS bf16_t* T = (LAS bf16_t*)lds;
          for (int t = eb; t < (SEQ / 64) * 16; t += EG) { const int rt = t >> 4, ct = t & 15;
              { const int r = tid >> 3, ch = tid & 7; const u32x4 v = *(const u32x4*)(projng + (size_t)(rt * 64 + r) * NG + C_DAV + ct * 64 + ch * 8);
                LAS bf16_t* tp = T + (ch * 8) * 72 + r;
                tp[0 * 72] = (bf16_t)(v.x & 0xffff); tp[1 * 72] = (bf16_t)(v.x >> 16); tp[2 * 72] = (bf16_t)(v.y & 0xffff); tp[3 * 72] = (bf16_t)(v.y >> 16);
                tp[4 * 72] = (bf16_t)(v.z & 0xffff); tp[5 * 72] = (bf16_t)(v.z >> 16); tp[6 * 72] = (bf16_t)(v.w & 0xffff); tp[7 * 72] = (bf16_t)(v.w >> 16); }
              __syncthreads();
              { const int c = tid >> 3, ch = tid & 7; const u32x4 v = *(const LAS u32x4*)(T + c * 72 + ch * 8); const int dvg = ct * 64 + c, hd = dvg >> 7, dvl = dvg & 127;
                *(u32x4*)(vimg + ((((size_t)(hd * 256 + rt) * 8 + ch) * 128 + dvl) * 8)) = v; }
              __syncthreads(); }
          }
        }
    }
    SEAM(2);
    if (IN(3)) {
        for (int repr = 0; repr < DUP_R; ++repr)
        for (int u = bid; u < 1024; u += G) ret_r1_unit(lds, projng, retU, u >> 3, u & 7);
        { const float* mqg = p.in[I_MQG]; const float* mkg = p.in[I_MKG];
          for (int row = gw; row < NMEM; row += NGW) {
#pragma unroll
              for (int it = 0; it < 2; ++it) { const int hd = it * 2 + (lane >> 5), sub = lane & 31; bf16_t* ptr = kvm + (size_t)row * 2048 + hd * 256 + sub * 8; const u32x4 raw = *(const u32x4*)ptr;
                  float v[8] = {bf_lo(raw.x), bf_hi(raw.x), bf_lo(raw.y), bf_hi(raw.y), bf_lo(raw.z), bf_hi(raw.z), bf_lo(raw.w), bf_hi(raw.w)}; float ss = 0.f;
#pragma unroll
                  for (int j = 0; j < 8; ++j) ss += v[j] * v[j];
                  ss += __shfl_xor(ss, 1); ss += __shfl_xor(ss, 2); ss += __shfl_xor(ss, 4); ss += __shfl_xor(ss, 8); ss += __shfl_xor(ss, 16);
                  const float rs = (0.0625f * LOG2E) / sqrtf(ss * (1.0f / 256.0f) + EPS);
#pragma unroll
                  for (int j = 0; j < 8; ++j) v[j] = v[j] * rs * mqg[sub * 8 + j] * mkg[sub * 8 + j];
                  u32x4 w; w.x = pk_bf16(v[0], v[1]); w.y = pk_bf16(v[2], v[3]); w.z = pk_bf16(v[4], v[5]); w.w = pk_bf16(v[6], v[7]); *(u32x4*)ptr = w; } } }
        { LAS bf16_t* T = (LAS bf16_t*)lds;
          for (int t = bid; t < 4 * 16; t += G) { const int rt = t >> 4, ct = t & 15; tile_transpose64(kvm, 2048, vtm, 256, rt * 64, 1024 + ct * 64, ct * 64, rt * 64, T, tid); } }
    }
    SEAM(3);
    if (IN(4)) {
        const int gid = bid * 512 + tid;
        for (int repr = 0; repr < DUP_R; ++repr)
        if (gid < 65536) { const int hd = gid >> 13, e = gid & 8191; const float cd = exp2f(128.0f * log2f(1.0f - exp2f(-5.0f - (float)hd))); float st = 0.f;
            const float* up = retU + (size_t)hd * 8192 + e; bf16_t* sp = states + (size_t)hd * 8192 + e;
#pragma unroll 8
            for (int c = 0; c < 128; ++c) { sp[(size_t)c * 65536] = (bf16_t)(pk_bf16(st, 0.f) & 0xffff); st = st * cd + up[(size_t)c * 65536]; } }
        { pg8::TileSched S; S.init(SEQ / 256, 4, 1, G, bid); S.A = (const char*)(projng + C_MQ); S.B = (const char*)kvm; S.a_tile_bytes = (size_t)256 * NG * 2; S.a_pn_bytes = 512; S.b_seg_bytes = 0; S.b_tile_bytes = 512;
          EpiMemS E{projng, rq, lmem};
          pg8::gemm_phase<EpiMemS, pg8::TileSched>(lds, NG, 2048, 256, S, E); }
        asm volatile("s_waitcnt vmcnt(0)" ::: "memory"); __syncthreads();
        { pg8::TileSched S; S.init(SEQ / 256, 4, 1, G, bid); S.A = (const char*)(projng + C_MQ); S.B = (const char*)vtm; S.a_tile_bytes = (size_t)256 * NG * 2; S.a_pn_bytes = 512; S.b_seg_bytes = 0; S.b_tile_bytes = (size_t)256 * 256 * 2;
          EpiMemO E{projng, lmem};
          pg8::gemm_phase<EpiMemO, pg8::TileSched>(lds, NG, 256, 256, S, E); }
    }
    SEAM(4);
    if (IN(5)) {
        for (int u = bid; u < 1024; u += G) ret_r3_unit(lds, projng, states, p.in[I_RNG], u >> 3, u & 7);
        float lam;
        { const int ln = (int)__builtin_amdgcn_mbcnt_hi(~0u, __builtin_amdgcn_mbcnt_lo(~0u, 0u));
          const float a = wave_sum(p.in[I_LQ1][ln] * p.in[I_LK1][ln]), b = wave_sum(p.in[I_LQ2][ln] * p.in[I_LK2][ln]); lam = expf(a) - expf(b) + 0.2f; }
#ifndef DUP_DA
#define DUP_DA 1
#endif
        for (int rep = 0; rep < DUP_DA; ++rep)
        for (int u = bid; u < 256; u += G) { const int head = u & 7, j = u >> 3;
            da_unit(lds, projng, kimg, vimg, p.in[I_SUBLN], head, 63 - j, lam);
            da_unit(lds, projng, kimg, vimg, p.in[I_SUBLN], head, j, lam); }
    }
    SEAM(5);
    if (IN(6)) {
        pg8::TileSched S; S.init(SEQ / 256, DM / 256, 3, G, bid, DUP_P6);
        S.A = (const char*)projng; S.B = (const char*)woda_t;
        S.a_tile_bytes = (size_t)256 * NG * 2; S.a_pn_bytes = 0; S.b_tile_bytes = (size_t)256 * 1024 * 2; S.b_seg_bytes = 4 * MiB;
        EpiMerge E{gda, (long)((char*)gmem - (char*)gda), merged};
        pg8::gemm_phase<EpiMerge, pg8::TileSched>(lds, NG, 1024, 1024, S, E);
    }
    SEAM(6);
    if (IN(7)) {
        pg8::TileSched S; S.init(SEQ / 256, DM / 256, 1, G, bid); S.A = (const char*)merged; S.B = (const char*)wout_t; S.a_tile_bytes = (size_t)256 * DM * 2; S.a_pn_bytes = 0; S.b_seg_bytes = 0; S.b_tile_bytes = (size_t)256 * DM * 2;
        EpiWout E{p.in[I_X], p.out, x1b, sumsq};
        pg8::gemm_phase<EpiWout, pg8::TileSched>(lds, DM, DM, DM, S, E);
    }
    SEAM(7);
    if (IN(8)) {
        pg8::TileSched S; S.init(SEQ / 256, 2 * DFF / 256, 1, G, bid, DUP_P8); S.A = (const char*)x1b; S.B = (const char*)wgu_t; S.a_tile_bytes = (size_t)256 * DM * 2; S.a_pn_bytes = 0; S.b_seg_bytes = 0; S.b_tile_bytes = (size_t)256 * DM * 2;
        EpiGateUp E{sumsq, hmid};
        pg8::gemm_phase<EpiGateUp, pg8::TileSched>(lds, DM, DM, DM, S, E);
    }
    SEAM(8);
    if (IN(9)) {
        pg8::TileSched S; S.init(SEQ / 256, DM / 256, 1, G, bid); S.A = (const char*)hmid; S.B = (const char*)wdn_t; S.a_tile_bytes = (size_t)256 * DFF * 2; S.a_pn_bytes = 0; S.b_seg_bytes = 0; S.b_tile_bytes = (size_t)256 * DFF * 2;
        EpiDown E{p.out};
        pg8::gemm_phase<EpiDown, pg8::TileSched>(lds, DFF, DFF, DFF, S, E);
    }
#undef IN
#undef SEAM
}

#ifndef N_LAUNCH_SPLIT
#define N_LAUNCH_SPLIT 0
#endif
extern "C" void kernel_launch(void* const* d_in, const int* in_sizes, int n_in, void* d_out, int out_size, void* d_ws, size_t ws_size, hipStream_t stream) {
    static int grid = 0;
    if (grid == 0) {
        if (n_in != 25 || ws_size < WS_END) { fprintf(stderr, "kernel_launch: unexpected n_in %d / ws_size %zu\n", n_in, ws_size); grid = -1; return; }
        int dev = 0, cus = 0, per_cu = 0;
        hipGetDevice(&dev); hipDeviceGetAttribute(&cus, hipDeviceAttributeMultiprocessorCount, dev);
        hipFuncSetAttribute((const void*)mega, hipFuncAttributeMaxDynamicSharedMemorySize, LDS_BYTES);
        if (hipOccupancyMaxActiveBlocksPerMultiprocessor(&per_cu, (const void*)mega, 512, LDS_BYTES) != hipSuccess || per_cu < 1) per_cu = 1;
        (void)hipGetLastError();
        grid = cus * 1;
        if (grid <= 0) grid = 256;
    }
    if (grid < 0) return;
    Params p{};
    for (int i = 0; i < 25; ++i) p.in[i] = (const float*)d_in[i];
    p.out = (float*)d_out; p.ws = (unsigned char*)d_ws;
    void* args[] = {&p};
#if N_LAUNCH_SPLIT
    for (int ph = 0; ph < 10; ++ph) { p.ph_lo = ph; p.ph_hi = ph + 1;
        hipError_t e = hipLaunchCooperativeKernel((const void*)mega, dim3(grid), dim3(512), args, LDS_BYTES, stream);
        if (e != hipSuccess) { fprintf(stderr, "cooperative launch failed: %s\n", hipGetErrorString(e)); break; } }
#else
    p.ph_lo = 0; p.ph_hi = 10;
    hipError_t e = hipLaunchCooperativeKernel((const void*)mega, dim3(grid), dim3(512), args, LDS_BYTES, stream);
    if (e != hipSuccess) fprintf(stderr, "cooperative launch failed: %s (grid %d)\n", hipGetErrorString(e), grid);
#endif
}
```

```cpp
#include <hip/hip_runtime.h>
#include <hip/hip_cooperative_groups.h>
#include <cstdio>
#include <cstdint>
namespace cg = cooperative_groups;
#ifndef DUP_P0
#define DUP_P0 1
#endif
#ifndef DUP_P1
#define DUP_P1 1
#endif
#ifndef DUP_P8
#define DUP_P8 1
#endif
#ifndef DUP_P6
#define DUP_P6 1
#endif
#ifndef DUP_R
#define DUP_R 1
#endif

#define LAS __attribute__((address_space(3)))
#define DI __device__ __forceinline__
typedef unsigned short bf16_t;
typedef short bf16x8 __attribute__((ext_vector_type(8)));
typedef float f32x4 __attribute__((ext_vector_type(4)));
typedef float f32x2 __attribute__((ext_vector_type(2)));
typedef float f32x16 __attribute__((ext_vector_type(16)));
typedef unsigned u32x4 __attribute__((ext_vector_type(4)));
typedef unsigned u32x2 __attribute__((ext_vector_type(2)));
typedef __bf16 bf16x2_t __attribute__((ext_vector_type(2)));

DI unsigned pk_bf16(float lo, float hi) { f32x2 v = {lo, hi}; bf16x2_t b = __builtin_convertvector(v, bf16x2_t); return __builtin_bit_cast(unsigned, b); }
DI float bf_lo(unsigned u) { return __uint_as_float(u << 16); }
DI float bf_hi(unsigned u) { return __uint_as_float(u & 0xffff0000u); }
DI float fexp2(float x) { return __builtin_amdgcn_exp2f(x); }
DI float frcp(float x) { return __builtin_amdgcn_rcpf(x); }
DI float frsq(float x) { return __builtin_amdgcn_rsqf(x); }
#define MFMA32(a, b, c) __builtin_amdgcn_mfma_f32_32x32x16_bf16((a), (b), (c), 0, 0, 0)

constexpr int SEQ = 16384, DM = 2048, NCOL = 13312, NG = 6144, DFF = 5632, NMEM = 256;
constexpr float EPS = 1e-6f;
constexpr float LOG2E = 1.4426950408889634f;
constexpr int C_DAQ = 0, C_DAV = 1024, C_RQ = 2048, C_RK = 2560, C_RV = 3072, C_RG = 4096, C_MQ = 5120;
constexpr size_t MiB = 1u << 20;
constexpr size_t WS_PROJ = 0;
constexpr size_t WS_X1B = 0, WS_HMID = 64 * MiB;
constexpr size_t WS_GMEM = 224 * MiB;
constexpr size_t WS_XB = 288 * MiB;
constexpr size_t WS_RETU = 288 * MiB, WS_STATES = 320 * MiB, WS_P = 336 * MiB, WS_VT = 368 * MiB, WS_MERGED = 288 * MiB;
constexpr size_t WS_WIN = 352 * MiB;
constexpr size_t WS_WKV = 404 * MiB, WS_WODA = 412 * MiB, WS_WORET = 416 * MiB, WS_WOMEM = 420 * MiB, WS_WOUT = 424 * MiB;
constexpr size_t WS_WGU = 432 * MiB, WS_WDN = 476 * MiB;
constexpr size_t WS_MISC = 498 * MiB;
constexpr size_t M_RCOS = WS_MISC, M_RSIN = WS_MISC + 2 * MiB, M_DCOS = WS_MISC + 4 * MiB, M_DSIN = WS_MISC + 4 * MiB + 512 * 1024;
constexpr size_t M_RSTDX = WS_MISC + 5 * MiB, M_SUMSQ = M_RSTDX + 65536, M_RQ = M_SUMSQ + 65536, M_LMEM = M_RQ + 262144, M_RSTDM = M_LMEM + 262144;
constexpr size_t M_BAR = M_RSTDM + 65536;
constexpr size_t M_MEMB = WS_MISC + 6 * MiB, M_KVM = WS_MISC + 7 * MiB, M_VTM = WS_MISC + 8 * MiB;
constexpr size_t WS_END = 512 * MiB;

namespace pg8 {
constexpr int BM = 256, BK = 64, HALF = 128, HTB = HALF * BK * 2, STAGE_BYTES = 8 * HTB, NXCD = 8, WGM = 8;
__host__ __device__ __forceinline__ int lds_byte(int r, int c) { const int st = (r >> 4) * 2 + (c >> 5), rr = r & 15, cc = c & 31, ob = rr * 64 + cc * 2; return st * 1024 + (ob ^ (((ob >> 9) & 1) << 5)); }
__host__ __device__ __forceinline__ void stage_rc(int b, int& R, int& C) { const int st = b / 1024, sb = b % 1024, swz = sb ^ (((sb >> 9) & 1) << 5); R = (st >> 1) * 16 + swz / 64; C = (st & 1) * 32 + (swz % 64) / 2; }
__host__ __device__ __forceinline__ int perm32(int rho) { const int n = rho >> 4, i = rho & 15; return 8 * (i >> 2) + 4 * n + (i & 3); }

struct Unit { int pm, pn, aux; };

struct TileSched {
    const char* A; const char* B;
    size_t a_tile_bytes, a_pn_bytes, b_tile_bytes, b_seg_bytes;
    int nM, nN, nwg, G, c, nseg, dup;
    DI void init(int nM_, int nN_, int nseg_, int G_, int c_, int dup_ = 1) { nM = nM_; nN = nN_; nwg = nM * nN; G = G_; c = c_; nseg = nseg_; dup = dup_; }
    DI bool next(int i, Unit& u) const {
        const int ti = i / nseg; u.aux = i - ti * nseg;
        long L = (long)ti * G + c; if (L >= (long)nwg * dup) return false; L %= nwg;
        int wgid = (int)L; { const int q = nwg / NXCD, r = nwg % NXCD, xcd = wgid % NXCD, off = wgid / NXCD; wgid = (xcd < r ? xcd * (q + 1) : r * (q + 1) + (xcd - r) * q) + off; }
        const int nig = WGM * nN, gid = wgid / nig, fm = gid * WGM, gsz = (nM - fm) < WGM ? (nM - fm) : WGM;
        u.pm = fm + ((wgid % nig) % gsz); u.pn = (wgid % nig) / gsz; return true;
    }
    DI const char* pa(const Unit& u) const { const int segcol = (nseg == 3) ? (u.aux == 0 ? C_DAV : (u.aux == 1 ? C_RG : C_MQ)) : 0; return A + (size_t)u.pm * a_tile_bytes + (size_t)u.pn * a_pn_bytes + (size_t)segcol * 2; }
    DI const char* pb(const Unit& u) const { return B + (size_t)u.pn * b_tile_bytes + (size_t)u.aux * b_seg_bytes; }
};

template <class Epi, class Sched>
__device__ __forceinline__ void gemm_phase(LAS unsigned char* lds, const int lda, const int ldb, const int K, const Sched& S, const Epi& E) {
    const int tid = threadIdx.x, wid = __builtin_amdgcn_readfirstlane(tid >> 6), lane = tid & 63, wr = wid >> 2, wc = wid & 3, fr = lane & 15, fq = lane >> 4;
    const int nt = K / BK;
    unsigned voffA[2], voffB[2];
#pragma unroll
    for (int i = 0; i < 2; ++i) { int R, C; stage_rc(tid * 16 + i * 8192, R, C); const int Rb = Epi::PERM ? ((R & ~31) + perm32(R & 31)) : R;
        voffA[i] = (unsigned)(R * lda + C) * 2u; voffB[i] = (unsigned)(Rb * ldb + C) * 2u; }
    const size_t kstep = (size_t)(BK * 2);
    const size_t hstepA = (size_t)HALF * lda * 2, hstepB = (size_t)HALF * ldb * 2;
    const unsigned ldsw = (unsigned)wid * 1024u;
    const int aoff = lds_byte(wr * 64 + fr, fq * 8), boff = lds_byte(wc * 32 + fr, fq * 8);
#define PG8_SA(b, h) (((b) * 2 + (h)) * HTB)
#define PG8_SB(b, h) ((4 + (b) * 2 + (h)) * HTB)
#define PG8_STAGE(bufoff, gbase, voff) do { _Pragma("unroll") for (int _i = 0; _i < 2; ++_i) \
        __builtin_amdgcn_global_load_lds((const unsigned*)((const char*)(gbase) + (voff)[_i]), (LAS unsigned*)(lds + (bufoff) + ldsw + _i * 8192), 16, 0, 0); } while (0)
#define PG8_LDA(dst, b, h) do { _Pragma("unroll") for (int m = 0; m < 4; ++m) _Pragma("unroll") for (int k = 0; k < 2; ++k) dst[m][k] = *(const LAS bf16x8*)(lds + PG8_SA(b, h) + aoff + m * 2048 + k * 1024); } while (0)
#define PG8_LDB(dst, b, h) do { _Pragma("unroll") for (int n = 0; n < 2; ++n) _Pragma("unroll") for (int k = 0; k < 2; ++k) dst[n][k] = *(const LAS bf16x8*)(lds + PG8_SB(b, h) + boff + n * 2048 + k * 1024); } while (0)
#define PG8_MMA(ai, bj, At, Bt) do { __builtin_amdgcn_s_setprio(1); _Pragma("unroll") for (int m = 0; m < 4; ++m) _Pragma("unroll") for (int n = 0; n < 2; ++n) _Pragma("unroll") for (int k = 0; k < 2; ++k) \
        acc[ai][bj][m][n] = __builtin_amdgcn_mfma_f32_16x16x32_bf16(Bt[n][k], At[m][k], acc[ai][bj][m][n], 0, 0, 0); __builtin_amdgcn_s_setprio(0); } while (0)
#define PG8_WAIT_V(n) asm volatile("s_waitcnt vmcnt(" #n ")" ::: "memory")
#define PG8_WAIT_L(n) asm volatile("s_waitcnt lgkmcnt(" #n ")" ::: "memory")
#define PG8_BAR __builtin_amdgcn_s_barrier()
#define PG8_SCHED __builtin_amdgcn_sched_barrier(0)
    Unit cur, nxt; int ui = 0;
    if (!S.next(0, cur)) return;
    f32x4 acc[2][2][4][2];
#pragma unroll
    for (int a = 0; a < 2; ++a)
#pragma unroll
        for (int b = 0; b < 2; ++b)
#pragma unroll
            for (int m = 0; m < 4; ++m)
#pragma unroll
                for (int n = 0; n < 2; ++n) acc[a][b][m][n] = (f32x4){0.f, 0.f, 0.f, 0.f};
    bf16x8 At[4][2], B0[2][2], B1[2][2];
    const char* cA = S.pa(cur); const char* cB = S.pb(cur);
    PG8_STAGE(PG8_SB(0, 0), cB, voffB); PG8_STAGE(PG8_SB(0, 1), cB + hstepB, voffB); PG8_STAGE(PG8_SA(0, 0), cA, voffA); PG8_STAGE(PG8_SA(0, 1), cA + hstepA, voffA);
    if (wr == 1) PG8_BAR;
    PG8_WAIT_V(2); PG8_BAR;
    PG8_STAGE(PG8_SB(1, 0), cB + kstep, voffB); PG8_STAGE(PG8_SA(1, 0), cA + kstep, voffA); PG8_STAGE(PG8_SB(1, 1), cB + hstepB + kstep, voffB);
    PG8_WAIT_V(6); PG8_BAR;
    for (;;) {
        const bool has_next = S.next(ui + 1, nxt);
        const char* nA = has_next ? S.pa(nxt) : cA; const char* nB = has_next ? S.pb(nxt) : cB;
#pragma unroll 1
        for (int t = 0; t < nt; t += 2) {
            const bool last = (t == nt - 2);
            const char* a1 = cA + (size_t)(t + 1) * kstep;
            const char* a2 = last ? nA : cA + (size_t)(t + 2) * kstep; const char* b2 = last ? nB : cB + (size_t)(t + 2) * kstep;
            const char* a3 = a2 + kstep; const char* b3 = b2 + kstep;
            PG8_LDB(B0, 0, 0); PG8_LDB(B1, 0, 1); PG8_SCHED; PG8_LDA(At, 0, 0); PG8_STAGE(PG8_SA(1, 1), a1 + hstepA, voffA);
            PG8_WAIT_V(8); PG8_WAIT_L(0); PG8_BAR; PG8_MMA(0, 0, At, B0); PG8_MMA(0, 1, At, B1); PG8_BAR; PG8_SCHED;
            PG8_LDA(At, 0, 1); PG8_STAGE(PG8_SB(0, 0), b2, voffB); PG8_STAGE(PG8_SB(0, 1), b2 + hstepB, voffB); PG8_STAGE(PG8_SA(0, 0), a2, voffA);
            PG8_WAIT_V(8); PG8_WAIT_L(0); PG8_BAR; PG8_MMA(1, 0, At, B0); PG8_MMA(1, 1, At, B1); PG8_BAR; PG8_SCHED;
            PG8_LDB(B0, 1, 0); PG8_LDB(B1, 1, 1); PG8_SCHED; PG8_LDA(At, 1, 0); PG8_STAGE(PG8_SA(0, 1), a2 + hstepA, voffA);
            PG8_WAIT_V(8); PG8_WAIT_L(0); PG8_BAR; PG8_MMA(0, 0, At, B0); PG8_MMA(0, 1, At, B1); PG8_BAR; PG8_SCHED;
            PG8_LDA(At, 1, 1); PG8_STAGE(PG8_SB(1, 0), b3, voffB); PG8_STAGE(PG8_SB(1, 1), b3 + hstepB, voffB); PG8_STAGE(PG8_SA(1, 0), a3, voffA);
            PG8_WAIT_V(8); PG8_WAIT_L(0); PG8_BAR; PG8_MMA(1, 0, At, B0); PG8_MMA(1, 1, At, B1); PG8_BAR; PG8_SCHED;
        }
        if (wr == 0) PG8_BAR;
        E(acc, cur, wr, wc, fr, fq);
        if (!has_next) break;
        if (!E.keep(cur)) {
#pragma unroll
            for (int a = 0; a < 2; ++a)
#pragma unroll
                for (int b = 0; b < 2; ++b)
#pragma unroll
                    for (int m = 0; m < 4; ++m)
#pragma unroll
                        for (int n = 0; n < 2; ++n) acc[a][b][m][n] = (f32x4){0.f, 0.f, 0.f, 0.f};
        }
        cur = nxt; cA = nA; cB = nB; ++ui;
        if (wr == 1) PG8_BAR;
    }
    PG8_WAIT_V(0);
    PG8_BAR;
#undef PG8_SA
#undef PG8_SB
#undef PG8_STAGE
#undef PG8_LDA
#undef PG8_LDB
#undef PG8_MMA
#undef PG8_WAIT_V
#undef PG8_WAIT_L
#undef PG8_BAR
#undef PG8_SCHED
}
}
using pg8::Unit;
typedef f32x4 Acc[2][2][4][2];

struct EpiRowScale {
    static constexpr bool PERM = true;
    bf16_t* d0; long gdelta; const float* rstd; int mode;
    DI bool keep(const Unit&) const { return false; }
    DI void operator()(Acc& acc, const Unit& u, int wr, int wc, int fr, int fq) const {
        bf16_t* base; int ld, colt;
        if (mode == 1) { base = d0; ld = 2048; colt = u.pn * 256; }
        else if (u.pn < 28) { base = d0; ld = NG; colt = u.pn * 256; }
        else { const int k = (u.pn - 28) >> 3; const long boff = (k < 2) ? (gdelta + (long)k * (long)(64 * MiB)) : (long)(WS_GMEM - WS_PROJ); base = (bf16_t*)((char*)d0 + boff); ld = 2048; colt = ((u.pn - 28) & 7) * 256; }
        const int row0 = u.pm * 256 + wr * 64 + fr, col0 = colt + wc * 32 + 8 * fq;
        float rsv[2][4];
#pragma unroll
        for (int ai = 0; ai < 2; ++ai)
#pragma unroll
            for (int m = 0; m < 4; ++m) rsv[ai][m] = rstd[row0 + ai * 128 + m * 16];
#pragma unroll
        for (int ai = 0; ai < 2; ++ai)
#pragma unroll
            for (int m = 0; m < 4; ++m) { const int row = row0 + ai * 128 + m * 16; const float rs = rsv[ai][m]; bf16_t* rowp = base + (size_t)row * ld + col0;
#pragma unroll
                for (int bj = 0; bj < 2; ++bj) { const f32x4 v0 = acc[ai][bj][m][0] * rs, v1 = acc[ai][bj][m][1] * rs;
                    u32x4 w; w.x = pk_bf16(v0[0], v0[1]); w.y = pk_bf16(v0[2], v0[3]); w.z = pk_bf16(v1[0], v1[1]); w.w = pk_bf16(v1[2], v1[3]);
                    *(u32x4*)(rowp + bj * 128) = w; } }
    }
};
struct EpiInProj {
    static constexpr bool PERM = true;
    unsigned char* wsb; long gdelta; const float* qg; const float* kg;
    DI bool keep(const Unit&) const { return false; }
    DI void operator()(Acc& acc, const Unit& u, int wr, int wc, int fr, int fq) const {
        bf16_t* d0 = (bf16_t*)(wsb + WS_PROJ); bf16_t* kimg = (bf16_t*)(wsb + 192 * MiB); const float* rstd = (const float*)(wsb + M_RSTDX); float* rqsum = (float*)(wsb + M_RQ);
        const float* dcos = (const float*)(wsb + M_DCOS); const float* dsin = (const float*)(wsb + M_DSIN); const float* rcos = (const float*)(wsb + M_RCOS); const float* rsin = (const float*)(wsb + M_RSIN);
        const int row0 = u.pm * 256 + wr * 64 + fr;
        float rsv[2][4];
#pragma unroll
        for (int ai = 0; ai < 2; ++ai)
#pragma unroll
            for (int m = 0; m < 4; ++m) rsv[ai][m] = rstd[row0 + ai * 128 + m * 16];
        if (u.pn < 8) {
            const bool isq = u.pn < 4; const float* gp = isq ? qg : kg;
            const f32x4 g00 = *(const f32x4*)(gp + 8 * fq), g01 = *(const f32x4*)(gp + 8 * fq + 4), g10 = *(const f32x4*)(gp + 32 + 8 * fq), g11 = *(const f32x4*)(gp + 32 + 8 * fq + 4);
            const float osc = isq ? (0.125f * LOG2E) : 1.0f;
            const int grp = (u.pn & 3) * 4 + wc;
#pragma unroll
            for (int ai = 0; ai < 2; ++ai)
#pragma unroll
                for (int m = 0; m < 4; ++m) { const int row = row0 + ai * 128 + m * 16; const float rs = rsv[ai][m];
                    f32x4 a0 = acc[ai][0][m][0] * rs, a1 = acc[ai][0][m][1] * rs, b0 = acc[ai][1][m][0] * rs, b1 = acc[ai][1][m][1] * rs;
                    float ss = 0.f;
#pragma unroll
                    for (int e = 0; e < 4; ++e) ss += a0[e] * a0[e] + a1[e] * a1[e] + b0[e] * b0[e] + b1[e] * b1[e];
                    ss += __shfl_xor(ss, 16); ss += __shfl_xor(ss, 32);
                    const float rn = 1.0f / sqrtf(ss * (1.0f / 64.0f) + EPS);
                    a0 = a0 * rn * g00; a1 = a1 * rn * g01; b0 = b0 * rn * g10; b1 = b1 * rn * g11;
                    { const f32x4 c0 = *(const f32x4*)(dcos + row * 8), c1 = *(const f32x4*)(dcos + row * 8 + 4), s0 = *(const f32x4*)(dsin + row * 8), s1 = *(const f32x4*)(dsin + row * 8 + 4);
                      f32x4 p0, p1;
#pragma unroll
                      for (int e = 0; e < 4; ++e) { p0[e] = __shfl_xor(a0[e], 16); p1[e] = __shfl_xor(a1[e], 16); }
                      if (fq == 0) { a0 = a0 * c0 - p0 * s0; a1 = a1 * c1 - p1 * s1; }
                      else if (fq == 1) { a0 = a0 * c0 + p0 * s0; a1 = a1 * c1 + p1 * s1; } }
                    a0 = a0 * osc; a1 = a1 * osc; b0 = b0 * osc; b1 = b1 * osc;
                    u32x4 wa, wb; wa.x = pk_bf16(a0[0], a0[1]); wa.y = pk_bf16(a0[2], a0[3]); wa.z = pk_bf16(a1[0], a1[1]); wa.w = pk_bf16(a1[2], a1[3]);
                    wb.x = pk_bf16(b0[0], b0[1]); wb.y = pk_bf16(b0[2], b0[3]); wb.z = pk_bf16(b1[0], b1[1]); wb.w = pk_bf16(b1[2], b1[3]);
                    if (isq) { bf16_t* qp = d0 + (size_t)row * NG + C_DAQ + grp * 64 + 8 * fq; *(u32x4*)qp = wa; *(u32x4*)(qp + 32) = wb; }
                    else { const int hd = grp >> 1, mp = grp & 1; bf16_t* kp = kimg + ((((size_t)(hd * 256 + (row >> 6)) * 16 + mp * 8 + fq) * 64 + (row & 63)) * 8);
                        *(u32x4*)kp = wa; *(u32x4*)(kp + 4 * 64 * 8) = wb; } }
            return;
        }
        if (u.pn >= 12 && u.pn < 16) {
            const float osc = (u.pn < 14) ? 1.0f : 0.125f;
            const int grp = (u.pn - 12) * 4 + wc;
#pragma unroll
            for (int ai = 0; ai < 2; ++ai)
#pragma unroll
                for (int m = 0; m < 4; ++m) { const int row = row0 + ai * 128 + m * 16; const float rs = rsv[ai][m];
                    const f32x4 a0 = acc[ai][0][m][0] * rs, a1 = acc[ai][0][m][1] * rs, b0 = acc[ai][1][m][0] * rs, b1 = acc[ai][1][m][1] * rs;
                    const f32x4 c0 = *(const f32x4*)(rcos + row * 32 + 8 * fq), c1 = *(const f32x4*)(rcos + row * 32 + 8 * fq + 4), s0 = *(const f32x4*)(rsin + row * 32 + 8 * fq), s1 = *(const f32x4*)(rsin + row * 32 + 8 * fq + 4);
                    const f32x4 x0 = (a0 * c0 - b0 * s0) * osc, x1 = (a1 * c1 - b1 * s1) * osc, y0 = (b0 * c0 + a0 * s0) * osc, y1 = (b1 * c1 + a1 * s1) * osc;
                    u32x4 wa, wb; wa.x = pk_bf16(x0[0], x0[1]); wa.y = pk_bf16(x0[2], x0[3]); wa.z = pk_bf16(x1[0], x1[1]); wa.w = pk_bf16(x1[2], x1[3]);
                    wb.x = pk_bf16(y0[0], y0[1]); wb.y = pk_bf16(y0[2], y0[3]); wb.z = pk_bf16(y1[0], y1[1]); wb.w = pk_bf16(y1[2], y1[3]);
                    bf16_t* qp = d0 + (size_t)row * NG + C_RQ + grp * 64 + 8 * fq; *(u32x4*)qp = wa; *(u32x4*)(qp + 32) = wb; }
            return;
        }
        bf16_t* base; int ld, colt;
        if (u.pn < 28) { base = d0; ld = NG; colt = (u.pn - 4) * 256; }
        else { const int k = (u.pn - 28) >> 3; const long boff = (k < 2) ? (gdelta + (long)k * (long)(64 * MiB)) : (long)(WS_GMEM - WS_PROJ); base = (bf16_t*)((char*)d0 + boff); ld = 2048; colt = ((u.pn - 28) & 7) * 256; }
        const bool ismq = (u.pn >= 24 && u.pn < 28);
        const int col0 = colt + wc * 32 + 8 * fq;
#pragma unroll
        for (int ai = 0; ai < 2; ++ai)
#pragma unroll
            for (int m = 0; m < 4; ++m) { const int row = row0 + ai * 128 + m * 16; const float rs = rsv[ai][m]; bf16_t* rowp = base + (size_t)row * ld + col0; float ss = 0.f;
#pragma unroll
                for (int bj = 0; bj < 2; ++bj) { const f32x4 v0 = acc[ai][bj][m][0] * rs, v1 = acc[ai][bj][m][1] * rs;
                    u32x4 w; w.x = pk_bf16(v0[0], v0[1]); w.y = pk_bf16(v0[2], v0[3]); w.z = pk_bf16(v1[0], v1[1]); w.w = pk_bf16(v1[2], v1[3]);
                    if (ismq) ss += (bf_lo(w.x) * bf_lo(w.x) + bf_hi(w.x) * bf_hi(w.x)) + (bf_lo(w.y) * bf_lo(w.y) + bf_hi(w.y) * bf_hi(w.y)) + (bf_lo(w.z) * bf_lo(w.z) + bf_hi(w.z) * bf_hi(w.z)) + (bf_lo(w.w) * bf_lo(w.w) + bf_hi(w.w) * bf_hi(w.w));
                    *(u32x4*)(rowp + bj * 128) = w; }
                if (ismq) { ss += __shfl_xor(ss, 16); ss += __shfl_xor(ss, 32); if (fq == 0) atomicAdd(rqsum + row * 4 + (u.pn - 24), ss); } }
    }
};
struct EpiMemS {
    static constexpr bool PERM = true;
    bf16_t* P; const float* rq; float* l;
    DI bool keep(const Unit&) const { return false; }
    DI void operator()(Acc& acc, const Unit& u, int wr, int wc, int fr, int fq) const {
        const int hd = u.pn, row0 = u.pm * 256 + wr * 64 + fr, col0 = hd * 256 + wc * 32 + 8 * fq;
        float rsv[2][4];
#pragma unroll
        for (int ai = 0; ai < 2; ++ai)
#pragma unroll
            for (int m = 0; m < 4; ++m) rsv[ai][m] = 1.0f / sqrtf(rq[(row0 + ai * 128 + m * 16) * 4 + hd] * (1.0f / 256.0f) + EPS);
#pragma unroll
        for (int ai = 0; ai < 2; ++ai)
#pragma unroll
            for (int m = 0; m < 4; ++m) { const int row = row0 + ai * 128 + m * 16; const float rs = rsv[ai][m]; bf16_t* rowp = P + (size_t)row * NG + C_MQ + col0; float sum = 0.f;
#pragma unroll
                for (int bj = 0; bj < 2; ++bj) { f32x4 v0 = acc[ai][bj][m][0] * rs, v1 = acc[ai][bj][m][1] * rs;
#pragma unroll
                    for (int e = 0; e < 4; ++e) { v0[e] = fexp2(v0[e]); v1[e] = fexp2(v1[e]); }
                    u32x4 w; w.x = pk_bf16(v0[0], v0[1]); w.y = pk_bf16(v0[2], v0[3]); w.z = pk_bf16(v1[0], v1[1]); w.w = pk_bf16(v1[2], v1[3]);
                    sum += (bf_lo(w.x) + bf_hi(w.x)) + (bf_lo(w.y) + bf_hi(w.y)) + (bf_lo(w.z) + bf_hi(w.z)) + (bf_lo(w.w) + bf_hi(w.w));
                    *(u32x4*)(rowp + bj * 128) = w; }
                sum += __shfl_xor(sum, 16); sum += __shfl_xor(sum, 32);
                if (fq == 0) atomicAdd(l + row * 4 + hd, sum); }
    }
};
struct EpiMemO {
    static constexpr bool PERM = true;
    bf16_t* O; float* l;
    DI bool keep(const Unit&) const { return false; }
    DI void operator()(Acc& acc, const Unit& u, int wr, int wc, int fr, int fq) const {
        const int hd = u.pn, row0 = u.pm * 256 + wr * 64 + fr, col0 = C_MQ + hd * 256 + wc * 32 + 8 * fq;
        float rsv[2][4];
#pragma unroll
        for (int ai = 0; ai < 2; ++ai)
#pragma unroll
            for (int m = 0; m < 4; ++m) rsv[ai][m] = __hip_atomic_load(l + (row0 + ai * 128 + m * 16) * 4 + hd, __ATOMIC_RELAXED, __HIP_MEMORY_SCOPE_AGENT);
#pragma unroll
        for (int ai = 0; ai < 2; ++ai)
#pragma unroll
            for (int m = 0; m < 4; ++m) { const int row = row0 + ai * 128 + m * 16;
                const float rs = frcp(rsv[ai][m]); bf16_t* rowp = O + (size_t)row * NG + col0;
#pragma unroll
                for (int bj = 0; bj < 2; ++bj) { const f32x4 v0 = acc[ai][bj][m][0] * rs, v1 = acc[ai][bj][m][1] * rs;
                    u32x4 w; w.x = pk_bf16(v0[0], v0[1]); w.y = pk_bf16(v0[2], v0[3]); w.z = pk_bf16(v1[0], v1[1]); w.w = pk_bf16(v1[2], v1[3]);
                    *(u32x4*)(rowp + bj * 128) = w; } }
    }
};
struct EpiMerge {
    static constexpr bool PERM = true;
    const bf16_t* g0; long gmem_delta; bf16_t* out;
    DI bool keep(const Unit& u) const { return u.aux < 2; }
    DI void operator()(Acc& acc, const Unit& u, int wr, int wc, int fr, int fq) const {
        const int seg = u.aux, row0 = u.pm * 256 + wr * 64 + fr, col0 = u.pn * 256 + wc * 32 + 8 * fq;
        const long offs = (seg < 2) ? (long)seg * (long)(64 * MiB) : gmem_delta; const long offn = (seg < 1) ? (long)(64 * MiB) : gmem_delta;
        const bf16_t* gs = (const bf16_t*)((const char*)g0 + offs); const bf16_t* gn = (const bf16_t*)((const char*)g0 + offn);
#pragma unroll
        for (int ai = 0; ai < 2; ++ai) {
            u32x4 ga[4][2], gb[4][2];
#pragma unroll
            for (int m = 0; m < 4; ++m)
#pragma unroll
                for (int bj = 0; bj < 2; ++bj) { const size_t off = (size_t)(row0 + ai * 128 + m * 16) * 2048 + col0 + bj * 128;
                    ga[m][bj] = *(const u32x4*)(gs + off); gb[m][bj] = (seg < 2) ? *(const u32x4*)(gn + off) : ga[m][bj]; }
#pragma unroll
            for (int m = 0; m < 4; ++m) { const size_t off = (size_t)(row0 + ai * 128 + m * 16) * 2048 + col0;
#pragma unroll
                for (int bj = 0; bj < 2; ++bj) {
                    const u32x4 a = ga[m][bj], b = gb[m][bj];
                    float es[8]; es[0] = bf_lo(a.x); es[1] = bf_hi(a.x); es[2] = bf_lo(a.y); es[3] = bf_hi(a.y); es[4] = bf_lo(a.z); es[5] = bf_hi(a.z); es[6] = bf_lo(a.w); es[7] = bf_hi(a.w);
                    float f[8];
                    if (seg < 2) {
                        float en[8]; en[0] = bf_lo(b.x); en[1] = bf_hi(b.x); en[2] = bf_lo(b.y); en[3] = bf_hi(b.y); en[4] = bf_lo(b.z); en[5] = bf_hi(b.z); en[6] = bf_lo(b.w); en[7] = bf_hi(b.w);
#pragma unroll
                        for (int e = 0; e < 8; ++e) f[e] = (1.f + fexp2(-LOG2E * en[e])) * frcp(1.f + fexp2(-LOG2E * es[e]));
                    } else {
#pragma unroll
                        for (int e = 0; e < 8; ++e) f[e] = frcp(1.f + fexp2(-LOG2E * es[e]));
                    }
                    f32x4 v0 = acc[ai][bj][m][0], v1 = acc[ai][bj][m][1];
#pragma unroll
                    for (int e = 0; e < 4; ++e) { v0[e] *= f[e]; v1[e] *= f[4 + e]; }
                    if (seg < 2) { acc[ai][bj][m][0] = v0; acc[ai][bj][m][1] = v1; }
                    else { u32x4 w; w.x = pk_bf16(v0[0], v0[1]); w.y = pk_bf16(v0[2], v0[3]); w.z = pk_bf16(v1[0], v1[1]); w.w = pk_bf16(v1[2], v1[3]);
                        *(u32x4*)(out + off + bj * 128) = w; } } }
        }
    }
};
struct EpiWout {
    static constexpr bool PERM = false;
    const float* x; float* out; bf16_t* x1b; float* sumsq;
    DI bool keep(const Unit&) const { return false; }
    DI void operator()(Acc& acc, const Unit& u, int wr, int wc, int fr, int fq) const {
        const int row0 = u.pm * 256 + wr * 64 + fr, col0 = u.pn * 256 + wc * 32 + 4 * fq;
#pragma unroll
        for (int ai = 0; ai < 2; ++ai) {
            f32x4 xv[4][2][2];
#pragma unroll
            for (int m = 0; m < 4; ++m)
#pragma unroll
                for (int bj = 0; bj < 2; ++bj)
#pragma unroll
                    for (int n = 0; n < 2; ++n) xv[m][bj][n] = *(const f32x4*)(x + (size_t)(row0 + ai * 128 + m * 16) * 2048 + col0 + bj * 128 + n * 16);
#pragma unroll
            for (int m = 0; m < 4; ++m) { const int row = row0 + ai * 128 + m * 16; const size_t off = (size_t)row * 2048 + col0; float ss = 0.f;
#pragma unroll
                for (int bj = 0; bj < 2; ++bj)
#pragma unroll
                    for (int n = 0; n < 2; ++n) { const size_t o = off + bj * 128 + n * 16; const f32x4 v = xv[m][bj][n] + acc[ai][bj][m][n];
                        *(f32x4*)(out + o) = v; ss += (v[0] * v[0] + v[1] * v[1]) + (v[2] * v[2] + v[3] * v[3]);
                        u32x2 w; w.x = pk_bf16(v[0], v[1]); w.y = pk_bf16(v[2], v[3]); *(u32x2*)(x1b + o) = w; }
                ss += __shfl_xor(ss, 16); ss += __shfl_xor(ss, 32);
                if (fq == 0) atomicAdd(sumsq + row, ss); }
        }
    }
};
struct EpiGateUp {
    static constexpr bool PERM = true;
    const float* sumsq; bf16_t* hmid;
    DI bool keep(const Unit&) const { return false; }
    DI void operator()(Acc& acc, const Unit& u, int wr, int wc, int fr, int fq) const {
        const int row0 = u.pm * 256 + wr * 64 + fr, col0 = u.pn * 128 + wc * 32 + 8 * fq;
        float rsv[2][4];
#pragma unroll
        for (int ai = 0; ai < 2; ++ai)
#pragma unroll
            for (int m = 0; m < 4; ++m) rsv[ai][m] = sumsq[row0 + ai * 128 + m * 16];
#pragma unroll
        for (int ai = 0; ai < 2; ++ai)
#pragma unroll
            for (int m = 0; m < 4; ++m) { const int row = row0 + ai * 128 + m * 16; const float rs = frsq(rsv[ai][m] * (1.0f / 2048.0f) + EPS);
                float hv[8];
#pragma unroll
                for (int n = 0; n < 2; ++n)
#pragma unroll
                    for (int e = 0; e < 4; ++e) { const float gg = acc[ai][0][m][n][e] * rs, uu = acc[ai][1][m][n][e] * rs; hv[n * 4 + e] = gg * frcp(1.f + fexp2(-LOG2E * gg)) * uu; }
                u32x4 w; w.x = pk_bf16(hv[0], hv[1]); w.y = pk_bf16(hv[2], hv[3]); w.z = pk_bf16(hv[4], hv[5]); w.w = pk_bf16(hv[6], hv[7]);
                *(u32x4*)(hmid + (size_t)row * DFF + col0) = w; }
    }
};
struct EpiDown {
    static constexpr bool PERM = false;
    float* out;
    DI bool keep(const Unit&) const { return false; }
    DI void operator()(Acc& acc, const Unit& u, int wr, int wc, int fr, int fq) const {
        const int row0 = u.pm * 256 + wr * 64 + fr, col0 = u.pn * 256 + wc * 32 + 4 * fq;
#pragma unroll
        for (int ai = 0; ai < 2; ++ai) {
            f32x4 xv[4][2][2];
#pragma unroll
            for (int m = 0; m < 4; ++m)
#pragma unroll
                for (int bj = 0; bj < 2; ++bj)
#pragma unroll
                    for (int n = 0; n < 2; ++n) xv[m][bj][n] = *(const f32x4*)(out + (size_t)(row0 + ai * 128 + m * 16) * 2048 + col0 + bj * 128 + n * 16);
#pragma unroll
            for (int m = 0; m < 4; ++m)
#pragma unroll
                for (int bj = 0; bj < 2; ++bj)
#pragma unroll
                    for (int n = 0; n < 2; ++n) *(f32x4*)(out + (size_t)(row0 + ai * 128 + m * 16) * 2048 + col0 + bj * 128 + n * 16) = xv[m][bj][n] + acc[ai][bj][m][n];
        }
    }
};

struct Params { const float* in[25]; float* out; unsigned char* ws; int ph_lo, ph_hi; };
enum { I_X = 0, I_MEM, I_POS, I_ANG, I_WIN, I_DQG, I_DKG, I_LQ1, I_LK1, I_LQ2, I_LK2, I_SUBLN, I_RNG, I_MNG, I_WKV, I_MQG, I_MKG, I_WODA, I_WORET, I_WOMEM, I_WOUT, I_FNG, I_WG, I_WU, I_WD };

DI float wave_sum(float v) {
#pragma unroll
    for (int o = 1; o < 64; o <<= 1) v += __shfl_xor(v, o);
    return v;
}

DI void transpose_item(const float* W, int K, int N, const float* g, bf16_t* WT, int rstride, int roff, LAS float* scr, int item, int lane, bool qkperm = false) {
    const int nblk = N / 32, kb = item / nblk, nb = item % nblk, k0 = 64 * kb, n0 = 32 * nb;
    float wv[32];
#pragma unroll
    for (int i = 0; i < 32; ++i) { const int kk = 2 * i + (lane >> 5); wv[i] = __builtin_nontemporal_load(W + (size_t)(k0 + kk) * N + n0 + (lane & 31));   }
    if (g) {
#pragma unroll
        for (int i = 0; i < 32; ++i) wv[i] *= g[k0 + 2 * i + (lane >> 5)];
    }
#pragma unroll
    for (int i = 0; i < 32; ++i) { const int kk = 2 * i + (lane >> 5); scr[kk * 33 + (lane & 31)] = wv[i]; }
    asm volatile("s_waitcnt lgkmcnt(0)" ::: "memory");
    const int c = lane & 7;
#pragma unroll
    for (int j = 0; j < 4; ++j) { const int n = (lane >> 3) + 8 * j; const LAS float* s = scr + (8 * c) * 33 + n;
        u32x4 o; o.x = pk_bf16(s[0 * 33], s[1 * 33]); o.y = pk_bf16(s[2 * 33], s[3 * 33]); o.z = pk_bf16(s[4 * 33], s[5 * 33]); o.w = pk_bf16(s[6 * 33], s[7 * 33]);
        const int ng = n0 + n; int drow = (ng >> 7) * rstride + (ng & 127) + roff;
        if (qkperm && (ng < 2048 || (ng >= 3072 && ng < 4096))) drow = (ng & ~255) + 128 * ((ng >> 5) & 1) + 32 * ((ng >> 6) & 3) + (ng & 31);
        *(u32x4*)(WT + (size_t)drow * K + k0 + 8 * c) = o; }
    asm volatile("s_waitcnt lgkmcnt(0)" ::: "memory");
}
DI void row_to_bf16(const float* xrow, bf16_t* orow, float* rstd_out, int lane) {
    const f32x4* xr = (const f32x4*)xrow + lane; f32x4 v[8]; float s = 0.f;
#pragma unroll
    for (int j = 0; j < 8; ++j) { v[j] = xr[64 * j]; s += (v[j][0] * v[j][0] + v[j][1] * v[j][1]) + (v[j][2] * v[j][2] + v[j][3] * v[j][3]); }
    s = wave_sum(s);
    if (lane == 0) *rstd_out = 1.0f / sqrtf(s * (1.0f / 2048.0f) + EPS);
    u32x2* o8 = (u32x2*)orow + lane;
#pragma unroll
    for (int j = 0; j < 8; ++j) { u32x2 w; w.x = pk_bf16(v[j][0], v[j][1]); w.y = pk_bf16(v[j][2], v[j][3]); o8[64 * j] = w; }
}
DI void tile_transpose64(const bf16_t* src, int lds_, bf16_t* dst, int ldd, int r0, int c0, int dr0, int dc0, LAS bf16_t* T, int tid) {
    { const int r = tid >> 3, ch = tid & 7; const u32x4 v = *(const u32x4*)(src + (size_t)(r0 + r) * lds_ + c0 + ch * 8);
      LAS bf16_t* t = T + (ch * 8) * 72 + r;
      t[0 * 72] = (bf16_t)(v.x & 0xffff); t[1 * 72] = (bf16_t)(v.x >> 16); t[2 * 72] = (bf16_t)(v.y & 0xffff); t[3 * 72] = (bf16_t)(v.y >> 16);
      t[4 * 72] = (bf16_t)(v.z & 0xffff); t[5 * 72] = (bf16_t)(v.z >> 16); t[6 * 72] = (bf16_t)(v.w & 0xffff); t[7 * 72] = (bf16_t)(v.w >> 16); }
    __syncthreads();
    { const int c = tid >> 3, ch = tid & 7; const u32x4 v = *(const LAS u32x4*)(T + c * 72 + ch * 8);
      *(u32x4*)(dst + (size_t)(dr0 + c) * ldd + dc0 + ch * 8) = v; }
    __syncthreads();
}

DI int lane_id() { return (int)__builtin_amdgcn_mbcnt_hi(~0u, __builtin_amdgcn_mbcnt_lo(~0u, 0u)); }
DI int pi32(int r) { return (r & ~12) | ((r & 4) << 1) | ((r & 8) >> 1); }

template <bool MASK>
DI void da_tile(const LAS unsigned char* Kb, const LAS unsigned char* Vb, const LAS unsigned char* Qb, f32x16 (&o1)[4], f32x16 (&o2)[4], float& l1, float& l2, int qrel, int khmax) {
#pragma unroll
    for (int kh = 0; kh < 2; ++kh) {
        if (!MASK || kh <= khmax) {
        bf16x8 pf1[2], pf2[2];
#pragma unroll
        for (int m = 0; m < 2; ++m) {
            f32x16 sv = f32x16{};
#pragma unroll
            for (int kp = 0; kp < 2; ++kp) {
                bf16x8 kf[2], qf[2];
#pragma unroll
                for (int k2 = 0; k2 < 2; ++k2) { const int ks = 2 * kp + k2; kf[k2] = *(const LAS bf16x8*)(Kb + (8 * m + 2 * ks) * 1024 + kh * 512); qf[k2] = *(const LAS bf16x8*)(Qb + (8 * m + 2 * ks) * 512); }
#pragma unroll
                for (int k2 = 0; k2 < 2; ++k2) sv = MFMA32(kf[k2], qf[k2], sv);
            }
            __builtin_amdgcn_sched_barrier(0);
            float ls = 0.f;
#pragma unroll
            for (int i = 0; i < 16; ++i) { float pv = fexp2(sv[i]);
                if (MASK) { const int key = 32 * kh + 16 * (i >> 3) + (i & 7); pv = (key > qrel) ? 0.f : pv; }
                sv[i] = pv; ls += pv; }
            if (m == 0) l1 += ls; else l2 += ls;
#pragma unroll
            for (int sx = 0; sx < 2; ++sx) { u32x4 w;
                w.x = pk_bf16(sv[8 * sx + 0], sv[8 * sx + 1]); w.y = pk_bf16(sv[8 * sx + 2], sv[8 * sx + 3]); w.z = pk_bf16(sv[8 * sx + 4], sv[8 * sx + 5]); w.w = pk_bf16(sv[8 * sx + 6], sv[8 * sx + 7]);
                if (m == 0) pf1[sx] = __builtin_bit_cast(bf16x8, w); else pf2[sx] = __builtin_bit_cast(bf16x8, w); }
        }
#pragma unroll
        for (int dp = 0; dp < 2; ++dp) {
            bf16x8 vf[2][2];
#pragma unroll
            for (int d2 = 0; d2 < 2; ++d2)
#pragma unroll
                for (int sx = 0; sx < 2; ++sx) vf[d2][sx] = *(const LAS bf16x8*)(Vb + (4 * kh + 2 * sx) * 2048 + (2 * dp + d2) * 512);
#pragma unroll
            for (int d2 = 0; d2 < 2; ++d2)
#pragma unroll
                for (int sx = 0; sx < 2; ++sx) { o1[2 * dp + d2] = MFMA32(vf[d2][sx], pf1[sx], o1[2 * dp + d2]); o2[2 * dp + d2] = MFMA32(vf[d2][sx], pf2[sx], o2[2 * dp + d2]); }
            __builtin_amdgcn_sched_barrier(0);
        }
        }
    }
}

DI void da_unit(LAS unsigned char* lds, bf16_t* projng, const bf16_t* kimg, const bf16_t* vimg, const float* subln, int head, int qb, float lam) {
    const int tid = threadIdx.x, lane = lane_id(), r = lane & 31, h = lane >> 5; const int wid = __builtin_amdgcn_readfirstlane(tid >> 6);
    const int qw = qb * 256 + wid * 32, NT = 4 * (qb + 1);
    f32x16 o1[4], o2[4];
#pragma unroll
    for (int d = 0; d < 4; ++d) { o1[d] = f32x16{}; o2[d] = f32x16{}; }
    float l1 = 0.f, l2 = 0.f;
    const bf16_t* ksrc = kimg + (size_t)head * 256 * 8192 + (2 * wid) * 512 + lane * 8;
    const bf16_t* vsrc = vimg + (size_t)head * 256 * 8192 + wid * 1024 + lane * 8;
    LAS unsigned char* kdst = lds + (2 * wid) * 1024; LAS unsigned char* vdst = lds + 32768 + wid * 2048;
#define DA_DMA(t, buf) do { \
        __builtin_amdgcn_global_load_lds((const unsigned*)(ksrc + (size_t)(t) * 8192), (LAS unsigned*)(kdst + (buf) * 16384), 16, 0, 0); \
        __builtin_amdgcn_global_load_lds((const unsigned*)(ksrc + (size_t)(t) * 8192 + 512), (LAS unsigned*)(kdst + (buf) * 16384 + 1024), 16, 0, 0); \
        __builtin_amdgcn_global_load_lds((const unsigned*)(vsrc + (size_t)(t) * 8192), (LAS unsigned*)(vdst + (buf) * 16384), 16, 0, 0); \
        __builtin_amdgcn_global_load_lds((const unsigned*)(vsrc + (size_t)(t) * 8192 + 512), (LAS unsigned*)(vdst + (buf) * 16384 + 1024), 16, 0, 0); } while (0)
    { const bf16_t* qsrc = projng + (size_t)(qw + r) * NG + C_DAQ + head * 128 + h * 8; LAS unsigned char* qdst = lds + 65536 + wid * 8192;
#pragma unroll
      for (int j = 0; j < 8; ++j) __builtin_amdgcn_global_load_lds((const unsigned*)(qsrc + j * 16), (LAS unsigned*)(qdst + j * 1024), 16, 0, 0); }
    const int kbase = h * 1024 + pi32(r) * 16;
    const int vbase = h * 2048 + r * 16;
    const LAS unsigned char* Qb = lds + 65536 + wid * 8192 + h * 512 + r * 16;
    DA_DMA(0, 0);
    __syncthreads();
    const int n_full = (qw + 1) >> 6;
    for (int t = 0; t < n_full; ++t) {
        const int buf = t & 1;
        DA_DMA(t + 1, buf ^ 1);
        da_tile<false>(lds + buf * 16384 + kbase, lds + 32768 + buf * 16384 + vbase, Qb, o1, o2, l1, l2, 0, 1);
        __syncthreads();
    }
    for (int t = n_full; t < NT; ++t) {
        const int buf = t & 1;
        if (t + 1 < NT) DA_DMA(t + 1, buf ^ 1);
        if (64 * t <= qw + 31) da_tile<true>(lds + buf * 16384 + kbase, lds + 32768 + buf * 16384 + vbase, Qb, o1, o2, l1, l2, qw + r - 64 * t - 8 * h, (64 * t + 32 > qw + 31) ? 0 : 1);
        __syncthreads();
    }
#undef DA_DMA
    l1 += __shfl_xor(l1, 32); l2 += __shfl_xor(l2, 32);
    const float i1 = 1.0f / l1, i2 = lam / l2; float ss = 0.f;
#pragma unroll
    for (int db = 0; db < 4; ++db)
#pragma unroll
        for (int i = 0; i < 16; ++i) { const float v = o1[db][i] * i1 - o2[db][i] * i2; o1[db][i] = v; ss += v * v; }
    ss += __shfl_xor(ss, 32);
    const float rs = 0.8f / sqrtf(ss * (1.0f / 128.0f) + EPS);
    bf16_t* orow = projng + (size_t)(qw + r) * NG + C_DAV + head * 128 + 4 * h;
#pragma unroll
    for (int db = 0; db < 4; ++db)
#pragma unroll
        for (int g4 = 0; g4 < 4; ++g4) { const int dv = 32 * db + 8 * g4; const f32x4 gv = *(const f32x4*)(subln + dv + 4 * h);
            u32x2 w; w.x = pk_bf16(o1[db][4 * g4 + 0] * rs * gv[0], o1[db][4 * g4 + 1] * rs * gv[1]); w.y = pk_bf16(o1[db][4 * g4 + 2] * rs * gv[2], o1[db][4 * g4 + 3] * rs * gv[3]);
            *(u32x2*)(orow + dv) = w; }
}

DI void ret_load_vt(LAS bf16_t* VTs, const bf16_t* projng, int pos0, int hd, int tid) {
#pragma unroll
    for (int i = 0; i < 4; ++i) { const int id = tid + 512 * i, pos = id >> 4, ch = id & 15;
        const u32x4 v = *(const u32x4*)(projng + (size_t)(pos0 + pos) * NG + C_RV + hd * 128 + ch * 8);
        LAS bf16_t* t = VTs + (ch * 8) * 136 + pos;
        t[0 * 136] = (bf16_t)(v.x & 0xffff); t[1 * 136] = (bf16_t)(v.x >> 16); t[2 * 136] = (bf16_t)(v.y & 0xffff); t[3 * 136] = (bf16_t)(v.y >> 16);
        t[4 * 136] = (bf16_t)(v.z & 0xffff); t[5 * 136] = (bf16_t)(v.z >> 16); t[6 * 136] = (bf16_t)(v.w & 0xffff); t[7 * 136] = (bf16_t)(v.w >> 16); }
}
DI void ret_r1_unit(LAS unsigned char* lds, const bf16_t* projng, float* retU, int c, int hd) {
    const int tid = threadIdx.x, lane = lane_id(), r = lane & 31, h = lane >> 5; const int wid = __builtin_amdgcn_readfirstlane(tid >> 6);
    LAS bf16_t* VTs = (LAS bf16_t*)lds; LAS bf16_t* KTs = (LAS bf16_t*)(lds + 128 * 272);
    const int pos0 = c * 128; const float lg = log2f(1.0f - exp2f(-5.0f - (float)hd));
    ret_load_vt(VTs, projng, pos0, hd, tid);
#pragma unroll
    for (int i = 0; i < 2; ++i) { const int id = tid + 512 * i, pos = id >> 3, ch = id & 7;
        const u32x4 v = *(const u32x4*)(projng + (size_t)(pos0 + pos) * NG + C_RK + hd * 64 + ch * 8);
        const float kd = fexp2(lg * (float)(127 - pos));
        LAS bf16_t* t = KTs + (ch * 8) * 136 + pos;
        t[0 * 136] = (bf16_t)(pk_bf16(bf_lo(v.x) * kd, 0.f) & 0xffff); t[1 * 136] = (bf16_t)(pk_bf16(bf_hi(v.x) * kd, 0.f) & 0xffff);
        t[2 * 136] = (bf16_t)(pk_bf16(bf_lo(v.y) * kd, 0.f) & 0xffff); t[3 * 136] = (bf16_t)(pk_bf16(bf_hi(v.y) * kd, 0.f) & 0xffff);
        t[4 * 136] = (bf16_t)(pk_bf16(bf_lo(v.z) * kd, 0.f) & 0xffff); t[5 * 136] = (bf16_t)(pk_bf16(bf_hi(v.z) * kd, 0.f) & 0xffff);
        t[6 * 136] = (bf16_t)(pk_bf16(bf_lo(v.w) * kd, 0.f) & 0xffff); t[7 * 136] = (bf16_t)(pk_bf16(bf_hi(v.w) * kd, 0.f) & 0xffff); }
    __syncthreads();
    const int db = wid >> 1, nb = wid & 1; f32x16 acc = f32x16{};
#pragma unroll
    for (int ks = 0; ks < 8; ++ks) { const bf16x8 a = *(const LAS bf16x8*)(VTs + (32 * db + r) * 136 + 16 * ks + 8 * h); const bf16x8 b = *(const LAS bf16x8*)(KTs + (32 * nb + r) * 136 + 16 * ks + 8 * h);
        acc = MFMA32(a, b, acc); }
    float* up = retU + ((size_t)(c * 8 + hd) * 128 + 32 * db + 4 * h) * 64 + 32 * nb + r;
#pragma unroll
    for (int i = 0; i < 16; ++i) up[((i & 3) + 8 * (i >> 2)) * 64] = acc[i];
    __syncthreads();
}
DI void ret_r3_unit(LAS unsigned char* lds, bf16_t* projng, const bf16_t* states, const float* norm_g, int c, int hd) {
    const int tid = threadIdx.x, lane = lane_id(), r = lane & 31, h = lane >> 5; const int wid = __builtin_amdgcn_readfirstlane(tid >> 6);
    LAS bf16_t* VTs = (LAS bf16_t*)lds; LAS bf16_t* Ks = (LAS bf16_t*)(lds + 128 * 272); LAS float* red = (LAS float*)(lds + 128 * 272 + 128 * 144);
    const int pos0 = c * 128; const float lg = log2f(1.0f - exp2f(-5.0f - (float)hd));
    ret_load_vt(VTs, projng, pos0, hd, tid);
#pragma unroll
    for (int i = 0; i < 2; ++i) { const int id = tid + 512 * i, pos = id >> 3, ch = id & 7;
        const u32x4 v = *(const u32x4*)(projng + (size_t)(pos0 + pos) * NG + C_RK + hd * 64 + ch * 8);
        *(LAS u32x4*)(Ks + pos * 72 + ch * 8) = v; }
    const int qb = wid & 3, dh = wid >> 2, n = 32 * qb + r;
    bf16x8 qf[4];
    { const bf16_t* qrow = projng + (size_t)(pos0 + n) * NG + C_RQ + hd * 64 + 8 * h;
#pragma unroll
      for (int ks = 0; ks < 4; ++ks) qf[ks] = *(const bf16x8*)(qrow + 16 * ks); }
    f32x16 o[2];
    { const float qd = fexp2(lg * (float)(n + 1));
#pragma unroll
      for (int d2 = 0; d2 < 2; ++d2) { o[d2] = f32x16{}; const bf16_t* sp = states + ((size_t)(c * 8 + hd) * 128 + 32 * (2 * dh + d2) + r) * 64 + 8 * h;
#pragma unroll
          for (int ks = 0; ks < 4; ++ks) { const bf16x8 a = *(const bf16x8*)(sp + 16 * ks); o[d2] = MFMA32(a, qf[ks], o[d2]); }
#pragma unroll
          for (int i = 0; i < 16; ++i) o[d2][i] *= qd; } }
    __syncthreads();
    const int pr = pi32(r);
    for (int kb = 0; kb <= qb; ++kb) {
        f32x16 s = f32x16{};
#pragma unroll
        for (int ks = 0; ks < 4; ++ks) { const bf16x8 a = *(const LAS bf16x8*)(Ks + (32 * kb + pr) * 72 + 16 * ks + 8 * h); s = MFMA32(a, qf[ks], s); }
        bf16x8 pf[2];
#pragma unroll
        for (int i = 0; i < 16; ++i) { const int mk = 32 * kb + 16 * (i >> 3) + 8 * h + (i & 7); const int dlt = n - mk; s[i] = (dlt >= 0) ? s[i] * fexp2(lg * (float)dlt) : 0.f; }
#pragma unroll
        for (int sx = 0; sx < 2; ++sx) { u32x4 w; w.x = pk_bf16(s[8 * sx + 0], s[8 * sx + 1]); w.y = pk_bf16(s[8 * sx + 2], s[8 * sx + 3]); w.z = pk_bf16(s[8 * sx + 4], s[8 * sx + 5]); w.w = pk_bf16(s[8 * sx + 6], s[8 * sx + 7]);
            pf[sx] = __builtin_bit_cast(bf16x8, w); }
#pragma unroll
        for (int d2 = 0; d2 < 2; ++d2)
#pragma unroll
            for (int sx = 0; sx < 2; ++sx) { const bf16x8 a = *(const LAS bf16x8*)(VTs + (32 * (2 * dh + d2) + r) * 136 + 32 * kb + 16 * sx + 8 * h); o[d2] = MFMA32(a, pf[sx], o[d2]); }
    }
    float ss = 0.f;
#pragma unroll
    for (int d2 = 0; d2 < 2; ++d2)
#pragma unroll
        for (int i = 0; i < 16; ++i) ss += o[d2][i] * o[d2][i];
    ss += __shfl_xor(ss, 32);
    if (h == 0) red[wid * 32 + r] = ss;
    __syncthreads();
    const float tot = red[wid * 32 + r] + red[(wid ^ 4) * 32 + r];
    const float rs = 1.0f / sqrtf(tot * (1.0f / 128.0f) + EPS);
    bf16_t* grow = projng + (size_t)(pos0 + n) * NG + C_RG + hd * 128 + 4 * h;
#pragma unroll
    for (int d2 = 0; d2 < 2; ++d2)
#pragma unroll
        for (int g4 = 0; g4 < 4; ++g4) { const int dv = 32 * (2 * dh + d2) + 8 * g4; const f32x4 gv = *(const f32x4*)(norm_g + dv + 4 * h); const u32x2 gt = *(const u32x2*)(grow + dv);
            float ga[4] = {bf_lo(gt.x), bf_hi(gt.x), bf_lo(gt.y), bf_hi(gt.y)}; float y[4];
#pragma unroll
            for (int e = 0; e < 4; ++e) { const float sl = ga[e] * frcp(1.f + fexp2(-LOG2E * ga[e])); y[e] = o[d2][4 * g4 + e] * rs * gv[e] * sl; }
            u32x2 w; w.x = pk_bf16(y[0], y[1]); w.y = pk_bf16(y[2], y[3]); *(u32x2*)(grow + dv) = w; }
    __syncthreads();
}

#define XB_XCNT(j) (64 * (j))
#define XB_XSUB(j) (1024 + 64 * (j))
#define XB_XGEN(j) (2048 + 64 * (j))
#define XB_TOP 3072
#define XB_TOPGEN 3136
#define XB_WORDS 3200
DI unsigned xb_ld(unsigned* p) { return __hip_atomic_load(p, __ATOMIC_RELAXED, __HIP_MEMORY_SCOPE_AGENT); }
DI unsigned xb_add(unsigned* p, unsigned v) { return __hip_atomic_fetch_add(p, v, __ATOMIC_RELAXED, __HIP_MEMORY_SCOPE_AGENT); }
DI unsigned xb_xcc_id() { return (unsigned)__builtin_amdgcn_s_getreg((3 << 11) | 20) & 0xFu; }
DI void grid_bar(unsigned* bar, unsigned G, volatile LAS unsigned* st) {
    asm volatile("s_waitcnt vmcnt(0) lgkmcnt(0)" ::: "memory");
    __syncthreads();
    if (threadIdx.x == 0) {
        const unsigned x = xb_xcc_id();
        unsigned nloc = st[0], nx = st[1];
        if (nloc == 0u) {
            for (;;) { unsigned sum = 0u, cnt = 0u, mine = 0u;
#pragma unroll
                for (unsigned j = 0; j < 16; ++j) { const unsigned c = xb_ld(&bar[XB_XCNT(j)]); sum += c; cnt += (c > 0u) ? 1u : 0u; mine = (j == x) ? c : mine; }
                if (sum == G) { nloc = mine; nx = cnt; break; }
                __builtin_amdgcn_s_sleep(2); }
            st[0] = nloc; st[1] = nx; }
        const unsigned old = xb_add(&bar[XB_XSUB(x)], 1u);
        const unsigned gen = old / nloc;
        if (old + 1u == (gen + 1u) * nloc) {
            __builtin_amdgcn_fence(__ATOMIC_RELEASE, "agent");
            asm volatile("s_waitcnt vmcnt(0)" ::: "memory");
            const unsigned og = xb_add(&bar[XB_TOP], 1u);
            const unsigned tg = og / nx;
            if (og + 1u == (tg + 1u) * nx) xb_add(&bar[XB_TOPGEN], 1u);
            else while (xb_ld(&bar[XB_TOPGEN]) == tg) __builtin_amdgcn_s_sleep(1);
            __builtin_amdgcn_fence(__ATOMIC_ACQUIRE, "agent");
            xb_add(&bar[XB_XGEN(x)], 1u);
            asm volatile("s_waitcnt vmcnt(0)" ::: "memory");
        } else {
            while (xb_ld(&bar[XB_XGEN(x)]) == gen) __builtin_amdgcn_s_sleep(1);
            __builtin_amdgcn_fence(__ATOMIC_ACQUIRE, "agent");
            asm volatile("s_waitcnt vmcnt(0)" ::: "memory");
        }
    }
    __syncthreads();
}

constexpr int LDS_BYTES = 147456;
__global__ void __launch_bounds__(512, 2) mega(Params p) {
    extern __shared__ __attribute__((aligned(16))) unsigned char lds_raw[];
    LAS unsigned char* lds = (LAS unsigned char*)lds_raw;
    cg::grid_group grid = cg::this_grid();
    const int tid = threadIdx.x, lane = tid & 63; const int wave = __builtin_amdgcn_readfirstlane(tid >> 6);
    const int G = gridDim.x, bid = blockIdx.x;
    const int gw = bid * 8 + wave, NGW = G * 8;
    unsigned char* ws = p.ws;
    bf16_t* projng = (bf16_t*)(ws + WS_PROJ);
    bf16_t* gda = (bf16_t*)p.out; bf16_t* gret = (bf16_t*)((unsigned char*)p.out + 64 * MiB); bf16_t* gmem = (bf16_t*)(ws + WS_GMEM);
    bf16_t* xb = (bf16_t*)(ws + WS_XB);
    bf16_t* win_t = (bf16_t*)(ws + WS_WIN); bf16_t* wkv_t = (bf16_t*)(ws + WS_WKV);
    bf16_t* woda_t = (bf16_t*)(ws + WS_WODA); bf16_t* woret_t = (bf16_t*)(ws + WS_WORET); bf16_t* womem_t = (bf16_t*)(ws + WS_WOMEM); bf16_t* wout_t = (bf16_t*)(ws + WS_WOUT);
    bf16_t* wgu_t = (bf16_t*)(ws + WS_WGU); bf16_t* wdn_t = (bf16_t*)(ws + WS_WDN);
    float* rcos = (float*)(ws + M_RCOS); float* rsin = (float*)(ws + M_RSIN); float* dcos = (float*)(ws + M_DCOS); float* dsin = (float*)(ws + M_DSIN);
    float* rstdx = (float*)(ws + M_RSTDX); float* sumsq = (float*)(ws + M_SUMSQ); float* rq = (float*)(ws + M_RQ); float* lmem = (float*)(ws + M_LMEM); float* rstdm = (float*)(ws + M_RSTDM);
    bf16_t* memb = (bf16_t*)(ws + M_MEMB); bf16_t* kvm = (bf16_t*)(ws + M_KVM); bf16_t* vtm = (bf16_t*)(ws + M_VTM);
    float* retU = (float*)(ws + WS_RETU); bf16_t* states = (bf16_t*)(ws + WS_STATES); bf16_t* kimg = (bf16_t*)(ws + 192 * MiB);     bf16_t* vimg = (bf16_t*)(ws + WS_VT);
    bf16_t* merged = (bf16_t*)(ws + WS_MERGED); bf16_t* x1b = (bf16_t*)(ws + WS_X1B); bf16_t* hmid = (bf16_t*)(ws + WS_HMID);
    unsigned* barw = (unsigned*)(ws + M_BAR);
    volatile LAS unsigned* bst = (volatile LAS unsigned*)(lds + 131072 + 256);
    if (tid == 0) { bst[0] = 0u; bst[1] = 0u; }
    __syncthreads();
    const int lo = p.ph_lo, hi = p.ph_hi;
#ifndef PHASE_MASK
#define PHASE_MASK 0x3ff
#endif
#define IN(k) (((PHASE_MASK >> (k)) & 1) && lo <= (k) && (k) < hi)
#define SEAM(k) do { if (IN(k) && IN((k) + 1)) { if ((k) == 0) grid.sync(); else grid_bar(barw, (unsigned)G, bst); } } while (0)

    if (IN(0)) {
        LAS float* scr = (LAS float*)(lds + wave * 16384);
        const int I_WIN_N = 32 * (NCOL / 32), I_KV_N = 32 * 64, I_O_N = 16 * 64, I_OUT_N = 32 * 64, I_G_N = 32 * (DFF / 32), I_D_N = (DFF / 64) * 64;
        const int NITEMS = I_WIN_N + I_KV_N + 3 * I_O_N + I_OUT_N + 2 * I_G_N + I_D_N;
        for (int it = gw; it < NITEMS * DUP_P0; it += NGW) {
            int r = it % NITEMS;
            if (r < I_WIN_N) { transpose_item(p.in[I_WIN], DM, NCOL, p.in[I_ANG], win_t, 128, 0, scr, r, lane, true); continue; } r -= I_WIN_N;
            if (r < I_KV_N) { transpose_item(p.in[I_WKV], DM, 2048, p.in[I_MNG], wkv_t, 128, 0, scr, r, lane); continue; } r -= I_KV_N;
            if (r < I_O_N) { transpose_item(p.in[I_WODA], 1024, DM, nullptr, woda_t, 128, 0, scr, r, lane); continue; } r -= I_O_N;
            if (r < I_O_N) { transpose_item(p.in[I_WORET], 1024, DM, nullptr, woret_t, 128, 0, scr, r, lane); continue; } r -= I_O_N;
            if (r < I_O_N) { transpose_item(p.in[I_WOMEM], 1024, DM, nullptr, womem_t, 128, 0, scr, r, lane); continue; } r -= I_O_N;
            if (r < I_OUT_N) { transpose_item(p.in[I_WOUT], DM, DM, nullptr, wout_t, 128, 0, scr, r, lane); continue; } r -= I_OUT_N;
            if (r < I_G_N) { transpose_item(p.in[I_WG], DM, DFF, p.in[I_FNG], wgu_t, 256, 0, scr, r, lane); continue; } r -= I_G_N;
            if (r < I_G_N) { transpose_item(p.in[I_WU], DM, DFF, p.in[I_FNG], wgu_t, 256, 128, scr, r, lane); continue; } r -= I_G_N;
            transpose_item(p.in[I_WD], DFF, DM, nullptr, wdn_t, 128, 0, scr, r, lane);
        }
        for (int m = gw; m < SEQ; m += NGW) row_to_bf16(p.in[I_X] + (size_t)m * DM, xb + (size_t)m * DM, rstdx + m, lane);
        for (int m = gw; m < NMEM; m += NGW) row_to_bf16(p.in[I_MEM] + (size_t)m * DM, memb + (size_t)m * DM, rstdm + m, lane);
        const int* posi = (const int*)p.in[I_POS];
        for (int i = bid * 512 + tid; i < SEQ * 40; i += G * 512) {
            const int row = i / 40, j = i - row * 40; const double pos = (double)posi[row];
            double inv; if (j < 32) inv = exp(-((double)j / 32.0) * 9.210340371976184); else inv = exp(-((double)(j - 32) / 8.0) * 13.122363377404328);
            const double turns = pos * inv * 0.15915494309189535; const float fr_ = (float)(turns - rint(turns));
            const float cs = __builtin_amdgcn_cosf(fr_), sn = __builtin_amdgcn_sinf(fr_);
            if (j < 32) { rcos[row * 32 + j] = cs; rsin[row * 32 + j] = sn; } else { dcos[row * 8 + j - 32] = cs; dsin[row * 8 + j - 32] = sn; }
        }
        if (bid == 0) for (int i = tid; i < XB_WORDS; i += 512) barw[i] = 0u;
        for (int i = bid * 512 + tid; i < SEQ; i += G * 512) sumsq[i] = 0.f;
        for (int i = bid * 512 + tid; i < SEQ * 4; i += G * 512) { lmem[i] = 0.f; rq[i] = 0.f; }
    }
    SEAM(0);
    if (IN(1)) {
        if (tid == 0) (void)xb_add(&barw[XB_XCNT(xb_xcc_id())], 1u);
        { pg8::TileSched S; S.init(SEQ / 256, NCOL / 256, 1, G, bid, DUP_P1); S.A = (const char*)xb; S.B = (const char*)win_t; S.a_tile_bytes = (size_t)256 * DM * 2; S.a_pn_bytes = 0; S.b_seg_bytes = 0; S.b_tile_bytes = (size_t)256 * DM * 2;
          EpiInProj E{ws, (long)((char*)p.out - (char*)projng), p.in[I_DQG], p.in[I_DKG]};
          pg8::gemm_phase<EpiInProj, pg8::TileSched>(lds, DM, DM, DM, S, E); }
    }
    SEAM(1);
    if (IN(2)) {
        const bool kvblk = (G > 16) && (bid < 8);
        const int eb = (G > 16) ? bid - 8 : bid, EG = (G > 16) ? G - 8 : G;
        if (kvblk || G <= 16) {
          pg8::TileSched S; S.init(1, 8, 1, (G > 16) ? 8 : G, bid); S.A = (const char*)memb; S.B = (const char*)wkv_t; S.a_tile_bytes = (size_t)256 * DM * 2; S.a_pn_bytes = 0; S.b_seg_bytes = 0; S.b_tile_bytes = (size_t)256 * DM * 2;
          EpiRowScale E{kvm, 0, rstdm, 1};
          pg8::gemm_phase<EpiRowScale, pg8::TileSched>(lds, DM, DM, DM, S, E); }
        if (!kvblk) {
        { LAS bf16_t* T = (LAS bf16_t*)lds;
          for (int t = eb; t < (SEQ / 64) * 16; t += EG) { const int rt = t >> 4, ct = t & 15;
              { const int r = tid >> 3, ch = tid & 7; const u32x4 v = *(const u32x4*)(projng + (size_t)(rt * 64 + r) * NG + C_DAV + ct * 64 + ch * 8);
                LAS bf16_t* tp = T + (ch * 8) * 72 + r;
                tp[0 * 72] = (bf16_t)(v.x & 0xffff); tp[1 * 72] = (bf16_t)(v.x >> 16); tp[2 * 72] = (bf16_t)(v.y & 0xffff); tp[3 * 72] = (bf16_t)(v.y >> 16);
                tp[4 * 72] = (bf16_t)(v.z & 0xffff); tp[5 * 72] = (bf16_t)(v.z >> 16); tp[6 * 72] = (bf16_t)(v.w & 0xffff); tp[7 * 72] = (bf16_t)(v.w >> 16); }
              __syncthreads();
              { const int c = tid >> 3, ch = tid & 7; const u32x4 v = *(const LAS u32x4*)(T + c * 72 + ch * 8); const int dvg = ct * 64 + c, hd = dvg >> 7, dvl = dvg & 127;
                *(u32x4*)(vimg + ((((size_t)(hd * 256 + rt) * 8 + ch) * 128 + dvl) * 8)) = v; }
              __syncthreads(); }
          }
        }
    }
    SEAM(2);
    if (IN(3)) {
        for (int repr = 0; repr < DUP_R; ++repr)
        for (int u = bid; u < 1024; u += G) ret_r1_unit(lds, projng, retU, u >> 3, u & 7);
        { const float* mqg = p.in[I_MQG]; const float* mkg = p.in[I_MKG];
          for (int row = gw; row < NMEM; row += NGW) {
#pragma unroll
              for (int it = 0; it < 2; ++it) { const int hd = it * 2 + (lane >> 5), sub = lane & 31; bf16_t* ptr = kvm + (size_t)row * 2048 + hd * 256 + sub * 8; const u32x4 raw = *(const u32x4*)ptr;
                  float v[8] = {bf_lo(raw.x), bf_hi(raw.x), bf_lo(raw.y), bf_hi(raw.y), bf_lo(raw.z), bf_hi(raw.z), bf_lo(raw.w), bf_hi(raw.w)}; float ss = 0.f;
#pragma unroll
                  for (int j = 0; j < 8; ++j) ss += v[j] * v[j];
                  ss += __shfl_xor(ss, 1); ss += __shfl_xor(ss, 2); ss += __shfl_xor(ss, 4); ss += __shfl_xor(ss, 8); ss += __shfl_xor(ss, 16);
                  const float rs = (0.0625f * LOG2E) / sqrtf(ss * (1.0f / 256.0f) + EPS);
#pragma unroll
                  for (int j = 0; j < 8; ++j) v[j] = v[j] * rs * mqg[sub * 8 + j] * mkg[sub * 8 + j];
                  u32x4 w; w.x = pk_bf16(v[0], v[1]); w.y = pk_bf16(v[2], v[3]); w.z = pk_bf16(v[4], v[5]); w.w = pk_bf16(v[6], v[7]); *(u32x4*)ptr = w; } } }
        { LAS bf16_t* T = (LAS bf16_t*)lds;
          for (int t = bid; t < 4 * 16; t += G) { const int rt = t >> 4, ct = t & 15; tile_transpose64(kvm, 2048, vtm, 256, rt * 64, 1024 + ct * 64, ct * 64, rt * 64, T, tid); } }
    }
    SEAM(3);
    if (IN(4)) {
        const int gid = bid * 512 + tid;
        for (int repr = 0; repr < DUP_R; ++repr)
        if (gid < 65536) { const int hd = gid >> 13, e = gid & 8191; const float cd = exp2f(128.0f * log2f(1.0f - exp2f(-5.0f - (float)hd))); float st = 0.f;
            const float* up = retU + (size_t)hd * 8192 + e; bf16_t* sp = states + (size_t)hd * 8192 + e;
#pragma unroll 8
            for (int c = 0; c < 128; ++c) { sp[(size_t)c * 65536] = (bf16_t)(pk_bf16(st, 0.f) & 0xffff); st = st * cd + up[(size_t)c * 65536]; } }
        { pg8::TileSched S; S.init(SEQ / 256, 4, 1, G, bid); S.A = (const char*)(projng + C_MQ); S.B = (const char*)kvm; S.a_tile_bytes = (size_t)256 * NG * 2; S.a_pn_bytes = 512; S.b_seg_bytes = 0; S.b_tile_bytes = 512;
          EpiMemS E{projng, rq, lmem};
          pg8::gemm_phase<EpiMemS, pg8::TileSched>(lds, NG, 2048, 256, S, E); }
        asm volatile("s_waitcnt vmcnt(0)" ::: "memory"); __syncthreads();
        { pg8::TileSched S; S.init(SEQ / 256, 4, 1, G, bid); S.A = (const char*)(projng + C_MQ); S.B = (const char*)vtm; S.a_tile_bytes = (size_t)256 * NG * 2; S.a_pn_bytes = 512; S.b_seg_bytes = 0; S.b_tile_bytes = (size_t)256 * 256 * 2;
          EpiMemO E{projng, lmem};
          pg8::gemm_phase<EpiMemO, pg8::TileSched>(lds, NG, 256, 256, S, E); }
    }
    SEAM(4);
    if (IN(5)) {
        for (int u = bid; u < 1024; u += G) ret_r3_unit(lds, projng, states, p.in[I_RNG], u >> 3, u & 7);
        float lam;
        { const int ln = (int)__builtin_amdgcn_mbcnt_hi(~0u, __builtin_amdgcn_mbcnt_lo(~0u, 0u));
          const float a = wave_sum(p.in[I_LQ1][ln] * p.in[I_LK1][ln]), b = wave_sum(p.in[I_LQ2][ln] * p.in[I_LK2][ln]); lam = expf(a) - expf(b) + 0.2f; }
#ifndef DUP_DA
#define DUP_DA 1
#endif
        for (int rep = 0; rep < DUP_DA; ++rep)
        for (int u = bid; u < 256; u += G) { const int head = u & 7, j = u >> 3;
            da_unit(lds, projng, kimg, vimg, p.in[I_SUBLN], head, 63 - j, lam);
            da_unit(lds, projng, kimg, vimg, p.in[I_SUBLN], head, j, lam); }
    }
    SEAM(5);
    if (IN(6)) {
        pg8::TileSched S; S.init(SEQ / 256, DM / 256, 3, G, bid, DUP_P6);
        S.A = (const char*)projng; S.B = (const char*)woda_t;
        S.a_tile_bytes = (size_t)256 * NG * 2; S.a_pn_bytes = 0; S.b_tile_bytes = (size_t)256 * 1024 * 2; S.b_seg_bytes = 4 * MiB;
        EpiMerge E{gda, (long)((char*)gmem - (char*)gda), merged};
        pg8::gemm_phase<EpiMerge, pg8::TileSched>(lds, NG, 1024, 1024, S, E);
    }
    SEAM(6);
    if (IN(7)) {
        pg8::TileSched S; S.init(SEQ / 256, DM / 256, 1, G, bid); S.A = (const char*)merged; S.B = (const char*)wout_t; S.a_tile_bytes = (size_t)256 * DM * 2; S.a_pn_bytes = 0; S.b_seg_bytes = 0; S.b_tile_bytes = (size_t)256 * DM * 2;
        EpiWout E{p.in[I_X], p.out, x1b, sumsq};
        pg8::gemm_phase<EpiWout, pg8::TileSched>(lds, DM, DM, DM, S, E);
    }
    SEAM(7);
    if (IN(8)) {
        pg8::TileSched S; S.init(SEQ / 256, 2 * DFF / 256, 1, G, bid, DUP_P8); S.A = (const char*)x1b; S.B = (const char*)wgu_t; S.a_tile_bytes = (size_t)256 * DM * 2; S.a_pn_bytes = 0; S.b_seg_bytes = 0; S.b_tile_bytes = (size_t)256 * DM * 2;
        EpiGateUp E{sumsq, hmid};
        pg8::gemm_phase<EpiGateUp, pg8::TileSched>(lds, DM, DM, DM, S, E);
    }
    SEAM(8);
    if (IN(9)) {
        pg8::TileSched S; S.init(SEQ / 256, DM / 256, 1, G, bid); S.A = (const char*)hmid; S.B = (const char*)wdn_t; S.a_tile_bytes = (size_t)256 * DFF * 2; S.a_pn_bytes = 0; S.b_seg_bytes = 0; S.b_tile_bytes = (size_t)256 * DFF * 2;
        EpiDown E{p.out};
        pg8::gemm_phase<EpiDown, pg8::TileSched>(lds, DFF, DFF, DFF, S, E);
    }
#undef IN
#undef SEAM
}

#ifndef N_LAUNCH_SPLIT
#define N_LAUNCH_SPLIT 0
#endif
extern "C" void kernel_launch(void* const* d_in, const int* in_sizes, int n_in, void* d_out, int out_size, void* d_ws, size_t ws_size, hipStream_t stream) {
    static int grid = 0;
    if (grid == 0) {
        if (n_in != 25 || ws_size < WS_END) { fprintf(stderr, "kernel_launch: unexpected n_in %d / ws_size %zu\n", n_in, ws_size); grid = -1; return; }
        int dev = 0, cus = 0, per_cu = 0;
        hipGetDevice(&dev); hipDeviceGetAttribute(&cus, hipDeviceAttributeMultiprocessorCount, dev);
        hipFuncSetAttribute((const void*)mega, hipFuncAttributeMaxDynamicSharedMemorySize, LDS_BYTES);
        if (hipOccupancyMaxActiveBlocksPerMultiprocessor(&per_cu, (const void*)mega, 512, LDS_BYTES) != hipSuccess || per_cu < 1) per_cu = 1;
        (void)hipGetLastError();
        grid = cus * 1;
        if (grid <= 0) grid = 256;
    }
    if (grid < 0) return;
    Params p{};
    for (int i = 0; i < 25; ++i) p.in[i] = (const float*)d_in[i];
    p.out = (float*)d_out; p.ws = (unsigned char*)d_ws;
    void* args[] = {&p};
#if N_LAUNCH_SPLIT
    for (int ph = 0; ph < 10; ++ph) { p.ph_lo = ph; p.ph_hi = ph + 1;
        hipError_t e = hipLaunchCooperativeKernel((const void*)mega, dim3(grid), dim3(512), args, LDS_BYTES, stream);
        if (e != hipSuccess) { fprintf(stderr, "cooperative launch failed: %s\n", hipGetErrorString(e)); break; } }
#else
    p.ph_lo = 0; p.ph_hi = 10;
    hipError_t e = hipLaunchCooperativeKernel((const void*)mega, dim3(grid), dim3(512), args, LDS_BYTES, stream);
    if (e != hipSuccess) fprintf(stderr, "cooperative launch failed: %s (grid %d)\n", hipGetErrorString(e), grid);
#endif
}
```

```cpp
#include <hip/hip_runtime.h>
#include <hip/hip_cooperative_groups.h>
#include <cstdio>
#include <cstdint>
namespace cg = cooperative_groups;
#ifndef DUP_P0
#define DUP_P0 1
#endif
#ifndef DUP_P1
#define DUP_P1 1
#endif
#ifndef DUP_P8
#define DUP_P8 1
#endif
#ifndef DUP_P6
#define DUP_P6 1
#endif
#ifndef DUP_R
#define DUP_R 1
#endif

#define LAS __attribute__((address_space(3)))
#define DI __device__ __forceinline__
typedef unsigned short bf16_t;
typedef short bf16x8 __attribute__((ext_vector_type(8)));
typedef float f32x4 __attribute__((ext_vector_type(4)));
typedef float f32x2 __attribute__((ext_vector_type(2)));
typedef float f32x16 __attribute__((ext_vector_type(16)));
typedef unsigned u32x4 __attribute__((ext_vector_type(4)));
typedef unsigned u32x2 __attribute__((ext_vector_type(2)));
typedef __bf16 bf16x2_t __attribute__((ext_vector_type(2)));

DI unsigned pk_bf16(float lo, float hi) { f32x2 v = {lo, hi}; bf16x2_t b = __builtin_convertvector(v, bf16x2_t); return __builtin_bit_cast(unsigned, b); }
DI float bf_lo(unsigned u) { return __uint_as_float(u << 16); }
DI float bf_hi(unsigned u) { return __uint_as_float(u & 0xffff0000u); }
DI float fexp2(float x) { return __builtin_amdgcn_exp2f(x); }
DI float frcp(float x) { return __builtin_amdgcn_rcpf(x); }
DI float frsq(float x) { return __builtin_amdgcn_rsqf(x); }
#define MFMA32(a, b, c) __builtin_amdgcn_mfma_f32_32x32x16_bf16((a), (b), (c), 0, 0, 0)

constexpr int SEQ = 16384, DM = 2048, NCOL = 13312, NG = 6144, DFF = 5632, NMEM = 256;
constexpr float EPS = 1e-6f;
constexpr float LOG2E = 1.4426950408889634f;
constexpr int C_DAQ = 0, C_DAV = 1024, C_RQ = 2048, C_RK = 2560, C_RV = 3072, C_RG = 4096, C_MQ = 5120;
constexpr size_t MiB = 1u << 20;
constexpr size_t WS_PROJ = 0;
constexpr size_t WS_X1B = 0, WS_HMID = 64 * MiB;
constexpr size_t WS_GMEM = 224 * MiB;
constexpr size_t WS_XB = 288 * MiB;
constexpr size_t WS_RETU = 288 * MiB, WS_STATES = 320 * MiB, WS_P = 336 * MiB, WS_VT = 368 * MiB, WS_MERGED = 288 * MiB;
constexpr size_t WS_WIN = 352 * MiB;
constexpr size_t WS_WKV = 404 * MiB, WS_WODA = 412 * MiB, WS_WORET = 416 * MiB, WS_WOMEM = 420 * MiB, WS_WOUT = 424 * MiB;
constexpr size_t WS_WGU = 432 * MiB, WS_WDN = 476 * MiB;
constexpr size_t WS_MISC = 498 * MiB;
constexpr size_t M_RCOS = WS_MISC, M_RSIN = WS_MISC + 2 * MiB, M_DCOS = WS_MISC + 4 * MiB, M_DSIN = WS_MISC + 4 * MiB + 512 * 1024;
constexpr size_t M_RSTDX = WS_MISC + 5 * MiB, M_SUMSQ = M_RSTDX + 65536, M_RQ = M_SUMSQ + 65536, M_LMEM = M_RQ + 262144, M_RSTDM = M_LMEM + 262144;
constexpr size_t M_BAR = M_RSTDM + 65536;
constexpr size_t M_MEMB = WS_MISC + 6 * MiB, M_KVM = WS_MISC + 7 * MiB, M_VTM = WS_MISC + 8 * MiB;
constexpr size_t WS_END = 512 * MiB;

namespace pg8 {
constexpr int BM = 256, BK = 64, HALF = 128, HTB = HALF * BK * 2, STAGE_BYTES = 8 * HTB, NXCD = 8, WGM = 8;
__host__ __device__ __forceinline__ int lds_byte(int r, int c) { const int st = (r >> 4) * 2 + (c >> 5), rr = r & 15, cc = c & 31, ob = rr * 64 + cc * 2; return st * 1024 + (ob ^ (((ob >> 9) & 1) << 5)); }
__host__ __device__ __forceinline__ void stage_rc(int b, int& R, int& C) { const int st = b / 1024, sb = b % 1024, swz = sb ^ (((sb >> 9) & 1) << 5); R = (st >> 1) * 16 + swz / 64; C = (st & 1) * 32 + (swz % 64) / 2; }
__host__ __device__ __forceinline__ int perm32(int rho) { const int n = rho >> 4, i = rho & 15; return 8 * (i >> 2) + 4 * n + (i & 3); }

struct Unit { int pm, pn, aux; };

struct TileSched {
    const char* A; const char* B;
    size_t a_tile_bytes, a_pn_bytes, b_tile_bytes, b_seg_bytes;
    int nM, nN, nwg, G, c, nseg, dup;
    DI void init(int nM_, int nN_, int nseg_, int G_, int c_, int dup_ = 1) { nM = nM_; nN = nN_; nwg = nM * nN; G = G_; c = c_; nseg = nseg_; dup = dup_; }
    DI bool next(int i, Unit& u) const {
        const int ti = i / nseg; u.aux = i - ti * nseg;
        long L = (long)ti * G + c; if (L >= (long)nwg * dup) return false; L %= nwg;
        int wgid = (int)L; { const int q = nwg / NXCD, r = nwg % NXCD, xcd = wgid % NXCD, off = wgid / NXCD; wgid = (xcd < r ? xcd * (q + 1) : r * (q + 1) + (xcd - r) * q) + off; }
        const int nig = WGM * nN, gid = wgid / nig, fm = gid * WGM, gsz = (nM - fm) < WGM ? (nM - fm) : WGM;
        u.pm = fm + ((wgid % nig) % gsz); u.pn = (wgid % nig) / gsz; return true;
    }
    DI const char* pa(const Unit& u) const { const int segcol = (nseg == 3) ? (u.aux == 0 ? C_DAV : (u.aux == 1 ? C_RG : C_MQ)) : 0; return A + (size_t)u.pm * a_tile_bytes + (size_t)u.pn * a_pn_bytes + (size_t)segcol * 2; }
    DI const char* pb(const Unit& u) const { return B + (size_t)u.pn * b_tile_bytes + (size_t)u.aux * b_seg_bytes; }
};

template <class Epi, class Sched>
__device__ __forceinline__ void gemm_phase(LAS unsigned char* lds, const int lda, const int ldb, const int K, const Sched& S, const Epi& E) {
    const int tid = threadIdx.x, wid = __builtin_amdgcn_readfirstlane(tid >> 6), lane = tid & 63, wr = wid >> 2, wc = wid & 3, fr = lane & 15, fq = lane >> 4;
    const int nt = K / BK;
    unsigned voffA[2], voffB[2];
#pragma unroll
    for (int i = 0; i < 2; ++i) { int R, C; stage_rc(tid * 16 + i * 8192, R, C); const int Rb = Epi::PERM ? ((R & ~31) + perm32(R & 31)) : R;
        voffA[i] = (unsigned)(R * lda + C) * 2u; voffB[i] = (unsigned)(Rb * ldb + C) * 2u; }
    const size_t kstep = (size_t)(BK * 2);
    const size_t hstepA = (size_t)HALF * lda * 2, hstepB = (size_t)HALF * ldb * 2;
    const unsigned ldsw = (unsigned)wid * 1024u;
    const int aoff = lds_byte(wr * 64 + fr, fq * 8), boff = lds_byte(wc * 32 + fr, fq * 8);
#define PG8_SA(b, h) (((b) * 2 + (h)) * HTB)
#define PG8_SB(b, h) ((4 + (b) * 2 + (h)) * HTB)
#define PG8_STAGE(bufoff, gbase, voff) do { _Pragma("unroll") for (int _i = 0; _i < 2; ++_i) \
        __builtin_amdgcn_global_load_lds((const unsigned*)((const char*)(gbase) + (voff)[_i]), (LAS unsigned*)(lds + (bufoff) + ldsw + _i * 8192), 16, 0, 0); } while (0)
#define PG8_LDA(dst, b, h) do { _Pragma("unroll") for (int m = 0; m < 4; ++m) _Pragma("unroll") for (int k = 0; k < 2; ++k) dst[m][k] = *(const LAS bf16x8*)(lds + PG8_SA(b, h) + aoff + m * 2048 + k * 1024); } while (0)
#define PG8_LDB(dst, b, h) do { _Pragma("unroll") for (int n = 0; n < 2; ++n) _Pragma("unroll") for (int k = 0; k < 2; ++k) dst[n][k] = *(const LAS bf16x8*)(lds + PG8_SB(b, h) + boff + n * 2048 + k * 1024); } while (0)
#define PG8_MMA(ai, bj, At, Bt) do { __builtin_amdgcn_s_setprio(1); _Pragma("unroll") for (int m = 0; m < 4; ++m) _Pragma("unroll") for (int n = 0; n < 2; ++n) _Pragma("unroll") for (int k = 0; k < 2; ++k) \
        acc[ai][bj][m][n] = __builtin_amdgcn_mfma_f32_16x16x32_bf16(Bt[n][k], At[m][k], acc[ai][bj][m][n], 0, 0, 0); __builtin_amdgcn_s_setprio(0); } while (0)
#define PG8_WAIT_V(n) asm volatile("s_waitcnt vmcnt(" #n ")" ::: "memory")
#define PG8_WAIT_L(n) asm volatile("s_waitcnt lgkmcnt(" #n ")" ::: "memory")
#define PG8_BAR __builtin_amdgcn_s_barrier()
#define PG8_SCHED __builtin_amdgcn_sched_barrier(0)
    Unit cur, nxt; int ui = 0;
    if (!S.next(0, cur)) return;
    f32x4 acc[2][2][4][2];
#pragma unroll
    for (int a = 0; a < 2; ++a)
#pragma unroll
        for (int b = 0; b < 2; ++b)
#pragma unroll
            for (int m = 0; m < 4; ++m)
#pragma unroll
                for (int n = 0; n < 2; ++n) acc[a][b][m][n] = (f32x4){0.f, 0.f, 0.f, 0.f};
    bf16x8 At[4][2], B0[2][2], B1[2][2];
    const char* cA = S.pa(cur); const char* cB = S.pb(cur);
    PG8_STAGE(PG8_SB(0, 0), cB, voffB); PG8_STAGE(PG8_SB(0, 1), cB + hstepB, voffB); PG8_STAGE(PG8_SA(0, 0), cA, voffA); PG8_STAGE(PG8_SA(0, 1), cA + hstepA, voffA);
    if (wr == 1) PG8_BAR;
    PG8_WAIT_V(2); PG8_BAR;
    PG8_STAGE(PG8_SB(1, 0), cB + kstep, voffB); PG8_STAGE(PG8_SA(1, 0), cA + kstep, voffA); PG8_STAGE(PG8_SB(1, 1), cB + hstepB + kstep, voffB);
    PG8_WAIT_V(6); PG8_BAR;
    for (;;) {
        const bool has_next = S.next(ui + 1, nxt);
        const char* nA = has_next ? S.pa(nxt) : cA; const char* nB = has_next ? S.pb(nxt) : cB;
#pragma unroll 1
        for (int t = 0; t < nt; t += 2) {
            const bool last = (t == nt - 2);
            const char* a1 = cA + (size_t)(t + 1) * kstep;
            const char* a2 = last ? nA : cA + (size_t)(t + 2) * kstep; const char* b2 = last ? nB : cB + (size_t)(t + 2) * kstep;
            const char* a3 = a2 + kstep; const char* b3 = b2 + kstep;
            PG8_LDB(B0, 0, 0); PG8_LDB(B1, 0, 1); PG8_SCHED; PG8_LDA(At, 0, 0); PG8_STAGE(PG8_SA(1, 1), a1 + hstepA, voffA);
            PG8_WAIT_V(8); PG8_WAIT_L(0); PG8_BAR; PG8_MMA(0, 0, At, B0); PG8_MMA(0, 1, At, B1); PG8_BAR; PG8_SCHED;
            PG8_LDA(At, 0, 1); PG8_STAGE(PG8_SB(0, 0), b2, voffB); PG8_STAGE(PG8_SB(0, 1), b2 + hstepB, voffB); PG8_STAGE(PG8_SA(0, 0), a2, voffA);
            PG8_WAIT_V(8); PG8_WAIT_L(0); PG8_BAR; PG8_MMA(1, 0, At, B0); PG8_MMA(1, 1, At, B1); PG8_BAR; PG8_SCHED;
            PG8_LDB(B0, 1, 0); PG8_LDB(B1, 1, 1); PG8_SCHED; PG8_LDA(At, 1, 0); PG8_STAGE(PG8_SA(0, 1), a2 + hstepA, voffA);
            PG8_WAIT_V(8); PG8_WAIT_L(0); PG8_BAR; PG8_MMA(0, 0, At, B0); PG8_MMA(0, 1, At, B1); PG8_BAR; PG8_SCHED;
            PG8_LDA(At, 1, 1); PG8_STAGE(PG8_SB(1, 0), b3, voffB); PG8_STAGE(PG8_SB(1, 1), b3 + hstepB, voffB); PG8_STAGE(PG8_SA(1, 0), a3, voffA);
            PG8_WAIT_V(8); PG8_WAIT_L(0); PG8_BAR; PG8_MMA(1, 0, At, B0); PG8_MMA(1, 1, At, B1); PG8_BAR; PG8_SCHED;
        }
        if (wr == 0) PG8_BAR;
        E(acc, cur, wr, wc, fr, fq);
        if (!has_next) break;
        if (!E.keep(cur)) {
#pragma unroll
            for (int a = 0; a < 2; ++a)
#pragma unroll
                for (int b = 0; b < 2; ++b)
#pragma unroll
                    for (int m = 0; m < 4; ++m)
#pragma unroll
                        for (int n = 0; n < 2; ++n) acc[a][b][m][n] = (f32x4){0.f, 0.f, 0.f, 0.f};
        }
        cur = nxt; cA = nA; cB = nB; ++ui;
        if (wr == 1) PG8_BAR;
    }
    PG8_WAIT_V(0);
    PG8_BAR;
#undef PG8_SA
#undef PG8_SB
#undef PG8_STAGE
#undef PG8_LDA
#undef PG8_LDB
#undef PG8_MMA
#undef PG8_WAIT_V
#undef PG8_WAIT_L
#undef PG8_BAR
#undef PG8_SCHED
}
}
using pg8::Unit;
typedef f32x4 Acc[2][2][4][2];

struct EpiRowScale {
    static constexpr bool PERM = true;
    bf16_t* d0; long gdelta; const float* rstd; int mode;
    DI bool keep(const Unit&) const { return false; }
    DI void operator()(Acc& acc, const Unit& u, int wr, int wc, int fr, int fq) const {
        bf16_t* base; int ld, colt;
        if (mode == 1) { base = d0; ld = 2048; colt = u.pn * 256; }
        else if (u.pn < 28) { base = d0; ld = NG; colt = u.pn * 256; }
        else { const int k = (u.pn - 28) >> 3; const long boff = (k < 2) ? (gdelta + (long)k * (long)(64 * MiB)) : (long)(WS_GMEM - WS_PROJ); base = (bf16_t*)((char*)d0 + boff); ld = 2048; colt = ((u.pn - 28) & 7) * 256; }
        const int row0 = u.pm * 256 + wr * 64 + fr, col0 = colt + wc * 32 + 8 * fq;
        float rsv[2][4];
#pragma unroll
        for (int ai = 0; ai < 2; ++ai)
#pragma unroll
            for (int m = 0; m < 4; ++m) rsv[ai][m] = rstd[row0 + ai * 128 + m * 16];
#pragma unroll
        for (int ai = 0; ai < 2; ++ai)
#pragma unroll
            for (int m = 0; m < 4; ++m) { const int row = row0 + ai * 128 + m * 16; const float rs = rsv[ai][m]; bf16_t* rowp = base + (size_t)row * ld + col0;
#pragma unroll
                for (int bj = 0; bj < 2; ++bj) { const f32x4 v0 = acc[ai][bj][m][0] * rs, v1 = acc[ai][bj][m][1] * rs;
                    u32x4 w; w.x = pk_bf16(v0[0], v0[1]); w.y = pk_bf16(v0[2], v0[3]); w.z = pk_bf16(v1[0], v1[1]); w.w = pk_bf16(v1[2], v1[3]);
                    *(u32x4*)(rowp + bj * 128) = w; } }
    }
};
struct EpiInProj {
    static constexpr bool PERM = true;
    unsigned char* wsb; long gdelta; const float* qg; const float* kg;
    DI bool keep(const Unit&) const { return false; }
    DI void operator()(Acc& acc, const Unit& u, int wr, int wc, int fr, int fq) const {
        bf16_t* d0 = (bf16_t*)(wsb + WS_PROJ); bf16_t* kimg = (bf16_t*)(wsb + 192 * MiB); const float* rstd = (const float*)(wsb + M_RSTDX); float* rqsum = (float*)(wsb + M_RQ);
        const float* dcos = (const float*)(wsb + M_DCOS); const float* dsin = (const float*)(wsb + M_DSIN); const float* rcos = (const float*)(wsb + M_RCOS); const float* rsin = (const float*)(wsb + M_RSIN);
        const int row0 = u.pm * 256 + wr * 64 + fr;
        float rsv[2][4];
#pragma unroll
        for (int ai = 0; ai < 2; ++ai)
#pragma unroll
            for (int m = 0; m < 4; ++m) rsv[ai][m] = rstd[row0 + ai * 128 + m * 16];
        if (u.pn < 8) {
            const bool isq = u.pn < 4; const float* gp = isq ? qg : kg;
            const f32x4 g00 = *(const f32x4*)(gp + 8 * fq), g01 = *(const f32x4*)(gp + 8 * fq + 4), g10 = *(const f32x4*)(gp + 32 + 8 * fq), g11 = *(const f32x4*)(gp + 32 + 8 * fq + 4);
            const float osc = isq ? (0.125f * LOG2E) : 1.0f;
            const int grp = (u.pn & 3) * 4 + wc;
#pragma unroll
            for (int ai = 0; ai < 2; ++ai)
#pragma unroll
                for (int m = 0; m < 4; ++m) { const int row = row0 + ai * 128 + m * 16; const float rs = rsv[ai][m];
                    f32x4 a0 = acc[ai][0][m][0] * rs, a1 = acc[ai][0][m][1] * rs, b0 = acc[ai][1][m][0] * rs, b1 = acc[ai][1][m][1] * rs;
                    float ss = 0.f;
#pragma unroll
                    for (int e = 0; e < 4; ++e) ss += a0[e] * a0[e] + a1[e] * a1[e] + b0[e] * b0[e] + b1[e] * b1[e];
                    ss += __shfl_xor(ss, 16); ss += __shfl_xor(ss, 32);
                    const float rn = 1.0f / sqrtf(ss * (1.0f / 64.0f) + EPS);
                    a0 = a0 * rn * g00; a1 = a1 * rn * g01; b0 = b0 * rn * g10; b1 = b1 * rn * g11;
                    { const f32x4 c0 = *(const f32x4*)(dcos + row * 8), c1 = *(const f32x4*)(dcos + row * 8 + 4), s0 = *(const f32x4*)(dsin + row * 8), s1 = *(const f32x4*)(dsin + row * 8 + 4);
                      f32x4 p0, p1;
#pragma unroll
                      for (int e = 0; e < 4; ++e) { p0[e] = __shfl_xor(a0[e], 16); p1[e] = __shfl_xor(a1[e], 16); }
                      if (fq == 0) { a0 = a0 * c0 - p0 * s0; a1 = a1 * c1 - p1 * s1; }
                      else if (fq == 1) { a0 = a0 * c0 + p0 * s0; a1 = a1 * c1 + p1 * s1; } }
                    a0 = a0 * osc; a1 = a1 * osc; b0 = b0 * osc; b1 = b1 * osc;
                    u32x4 wa, wb; wa.x = pk_bf16(a0[0], a0[1]); wa.y = pk_bf16(a0[2], a0[3]); wa.z = pk_bf16(a1[0], a1[1]); wa.w = pk_bf16(a1[2], a1[3]);
                    wb.x = pk_bf16(b0[0], b0[1]); wb.y = pk_bf16(b0[2], b0[3]); wb.z = pk_bf16(b1[0], b1[1]); wb.w = pk_bf16(b1[2], b1[3]);
                    if (isq) { bf16_t* qp = d0 + (size_t)row * NG + C_DAQ + grp * 64 + 8 * fq; *(u32x4*)qp = wa; *(u32x4*)(qp + 32) = wb; }
                    else { const int hd = grp >> 1, mp = grp & 1; bf16_t* kp = kimg + ((((size_t)(hd * 256 + (row >> 6)) * 16 + mp * 8 + fq) * 64 + (row & 63)) * 8);
                        *(u32x4*)kp = wa; *(u32x4*)(kp + 4 * 64 * 8) = wb; } }
            return;
        }
        if (u.pn >= 12 && u.pn < 16) {
            const float osc = (u.pn < 14) ? 1.0f : 0.125f;
            const int grp = (u.pn - 12) * 4 + wc;
#pragma unroll
            for (int ai = 0; ai < 2; ++ai)
#pragma unroll
                for (int m = 0; m < 4; ++m) { const int row = row0 + ai * 128 + m * 16; const float rs = rsv[ai][m];
                    const f32x4 a0 = acc[ai][0][m][0] * rs, a1 = acc[ai][0][m][1] * rs, b0 = acc[ai][1][m][0] * rs, b1 = acc[ai][1][m][1] * rs;
                    const f32x4 c0 = *(const f32x4*)(rcos + row * 32 + 8 * fq), c1 = *(const f32x4*)(rcos + row * 32 + 8 * fq + 4), s0 = *(const f32x4*)(rsin + row * 32 + 8 * fq), s1 = *(const f32x4*)(rsin + row * 32 + 8 * fq + 4);
                    const f32x4 x0 = (a0 * c0 - b0 * s0) * osc, x1 = (a1 * c1 - b1 * s1) * osc, y0 = (b0 * c0 + a0 * s0) * osc, y1 = (b1 * c1 + a1 * s1) * osc;
                    u32x4 wa, wb; wa.x = pk_bf16(x0[0], x0[1]); wa.y = pk_bf16(x0[2], x0[3]); wa.z = pk_bf16(x1[0], x1[1]); wa.w = pk_bf16(x1[2], x1[3]);
                    wb.x = pk_bf16(y0[0], y0[1]); wb.y = pk_bf16(y0[2], y0[3]); wb.z = pk_bf16(y1[0], y1[1]); wb.w = pk_bf16(y1[2], y1[3]);
                    bf16_t* qp = d0 + (size_t)row * NG + C_RQ + grp * 64 + 8 * fq; *(u32x4*)qp = wa; *(u32x4*)(qp + 32) = wb; }
            return;
        }
        bf16_t* base; int ld, colt;
        if (u.pn < 28) { base = d0; ld = NG; colt = (u.pn - 4) * 256; }
        else { const int k = (u.pn - 28) >> 3; const long boff = (k < 2) ? (gdelta + (long)k * (long)(64 * MiB)) : (long)(WS_GMEM - WS_PROJ); base = (bf16_t*)((char*)d0 + boff); ld = 2048; colt = ((u.pn - 28) & 7) * 256; }
        const bool ismq = (u.pn >= 24 && u.pn < 28);
        const int col0 = colt + wc * 32 + 8 * fq;
#pragma unroll
        for (int ai = 0; ai < 2; ++ai)
#pragma unroll
            for (int m = 0; m < 4; ++m) { const int row = row0 + ai * 128 + m * 16; const float rs = rsv[ai][m]; bf16_t* rowp = base + (size_t)row * ld + col0; float ss = 0.f;
#pragma unroll
                for (int bj = 0; bj < 2; ++bj) { const f32x4 v0 = acc[ai][bj][m][0] * rs, v1 = acc[ai][bj][m][1] * rs;
                    u32x4 w; w.x = pk_bf16(v0[0], v0[1]); w.y = pk_bf16(v0[2], v0[3]); w.z = pk_bf16(v1[0], v1[1]); w.w = pk_bf16(v1[2], v1[3]);
                    if (ismq) ss += (bf_lo(w.x) * bf_lo(w.x) + bf_hi(w.x) * bf_hi(w.x)) + (bf_lo(w.y) * bf_lo(w.y) + bf_hi(w.y) * bf_hi(w.y)) + (bf_lo(w.z) * bf_lo(w.z) + bf_hi(w.z) * bf_hi(w.z)) + (bf_lo(w.w) * bf_lo(w.w) + bf_hi(w.w) * bf_hi(w.w));
                    *(u32x4*)(rowp + bj * 128) = w; }
                if (ismq) { ss += __shfl_xor(ss, 16); ss += __shfl_xor(ss, 32); if (fq == 0) atomicAdd(rqsum + row * 4 + (u.pn - 24), ss); } }
    }
};
struct EpiMemS {
    static constexpr bool PERM = true;
    bf16_t* P; const float* rq; float* l;
    DI bool keep(const Unit&) const { return false; }
    DI void operator()(Acc& acc, const Unit& u, int wr, int wc, int fr, int fq) const {
        const int hd = u.pn, row0 = u.pm * 256 + wr * 64 + fr, col0 = hd * 256 + wc * 32 + 8 * fq;
        float rsv[2][4];
#pragma unroll
        for (int ai = 0; ai < 2; ++ai)
#pragma unroll
            for (int m = 0; m < 4; ++m) rsv[ai][m] = 1.0f / sqrtf(rq[(row0 + ai * 128 + m * 16) * 4 + hd] * (1.0f / 256.0f) + EPS);
#pragma unroll
        for (int ai = 0; ai < 2; ++ai)
#pragma unroll
            for (int m = 0; m < 4; ++m) { const int row = row0 + ai * 128 + m * 16; const float rs = rsv[ai][m]; bf16_t* rowp = P + (size_t)row * NG + C_MQ + col0; float sum = 0.f;
#pragma unroll
                for (int bj = 0; bj < 2; ++bj) { f32x4 v0 = acc[ai][bj][m][0] * rs, v1 = acc[ai][bj][m][1] * rs;
#pragma unroll
                    for (int e = 0; e < 4; ++e) { v0[e] = fexp2(v0[e]); v1[e] = fexp2(v1[e]); }
                    u32x4 w; w.x = pk_bf16(v0[0], v0[1]); w.y = pk_bf16(v0[2], v0[3]); w.z = pk_bf16(v1[0], v1[1]); w.w = pk_bf16(v1[2], v1[3]);
                    sum += (bf_lo(w.x) + bf_hi(w.x)) + (bf_lo(w.y) + bf_hi(w.y)) + (bf_lo(w.z) + bf_hi(w.z)) + (bf_lo(w.w) + bf_hi(w.w));
                    *(u32x4*)(rowp + bj * 128) = w; }
                sum += __shfl_xor(sum, 16); sum += __shfl_xor(sum, 32);
                if (fq == 0) atomicAdd(l + row * 4 + hd, sum); }
    }
};
struct EpiMemO {
    static constexpr bool PERM = true;
    bf16_t* O; float* l;
    DI bool keep(const Unit&) const { return false; }
    DI void operator()(Acc& acc, const Unit& u, int wr, int wc, int fr, int fq) const {
        const int hd = u.pn, row0 = u.pm * 256 + wr * 64 + fr, col0 = C_MQ + hd * 256 + wc * 32 + 8 * fq;
        float rsv[2][4];
#pragma unroll
        for (int ai = 0; ai < 2; ++ai)
#pragma unroll
            for (int m = 0; m < 4; ++m) rsv[ai][m] = __hip_atomic_load(l + (row0 + ai * 128 + m * 16) * 4 + hd, __ATOMIC_RELAXED, __HIP_MEMORY_SCOPE_AGENT);
#pragma unroll
        for (int ai = 0; ai < 2; ++ai)
#pragma unroll
            for (int m = 0; m < 4; ++m) { const int row = row0 + ai * 128 + m * 16;
                const float rs = frcp(rsv[ai][m]); bf16_t* rowp = O + (size_t)row * NG + col0;
#pragma unroll
                for (int bj = 0; bj < 2; ++bj) { const f32x4 v0 = acc[ai][bj][m][0] * rs, v1 = acc[ai][bj][m][1] * rs;
                    u32x4 w; w.x = pk_bf16(v0[0], v0[1]); w.y = pk_bf16(v0[2], v0[3]); w.z = pk_bf16(v1[0], v1[1]); w.w = pk_bf16(v1[2], v1[3]);
                    *(u32x4*)(rowp + bj * 128) = w; } }
    }
};
struct EpiMerge {
    static constexpr bool PERM = true;
    const bf16_t* g0; long gmem_delta; bf16_t* out;
    DI bool keep(const Unit& u) const { return u.aux < 2; }
    DI void operator()(Acc& acc, const Unit& u, int wr, int wc, int fr, int fq) const {
        const int seg = u.aux, row0 = u.pm * 256 + wr * 64 + fr, col0 = u.pn * 256 + wc * 32 + 8 * fq;
        const long offs = (seg < 2) ? (long)seg * (long)(64 * MiB) : gmem_delta; const long offn = (seg < 1) ? (long)(64 * MiB) : gmem_delta;
        const bf16_t* gs = (const bf16_t*)((const char*)g0 + offs); const bf16_t* gn = (const bf16_t*)((const char*)g0 + offn);
#pragma unroll
        for (int ai = 0; ai < 2; ++ai) {
            u32x4 ga[4][2], gb[4][2];
#pragma unroll
            for (int m = 0; m < 4; ++m)
#pragma unroll
                for (int bj = 0; bj < 2; ++bj) { const size_t off = (size_t)(row0 + ai * 128 + m * 16) * 2048 + col0 + bj * 128;
                    ga[m][bj] = *(const u32x4*)(gs + off); gb[m][bj] = (seg < 2) ? *(const u32x4*)(gn + off) : ga[m][bj]; }
#pragma unroll
            for (int m = 0; m < 4; ++m) { const size_t off = (size_t)(row0 + ai * 128 + m * 16) * 2048 + col0;
#pragma unroll
                for (int bj = 0; bj < 2; ++bj) {
                    const u32x4 a = ga[m][bj], b = gb[m][bj];
                    float es[8]; es[0] = bf_lo(a.x); es[1] = bf_hi(a.x); es[2] = bf_lo(a.y); es[3] = bf_hi(a.y); es[4] = bf_lo(a.z); es[5] = bf_hi(a.z); es[6] = bf_lo(a.w); es[7] = bf_hi(a.w);
                    float f[8];
                    if (seg < 2) {
                        float en[8]; en[0] = bf_lo(b.x); en[1] = bf_hi(b.x); en[2] = bf_lo(b.y); en[3] = bf_hi(b.y); en[4] = bf_lo(b.z); en[5] = bf_hi(b.z); en[6] = bf_lo(b.w); en[7] = bf_hi(b.w);
#pragma unroll
                        for (int e = 0; e < 8; ++e) f[e] = (1.f + fexp2(-LOG2E * en[e])) * frcp(1.f + fexp2(-LOG2E * es[e]));
                    } else {
#pragma unroll
                        for (int e = 0; e < 8; ++e) f[e] = frcp(1.f + fexp2(-LOG2E * es[e]));
                    }
                    f32x4 v0 = acc[ai][bj][m][0], v1 = acc[ai][bj][m][1];
#pragma unroll
                    for (int e = 0; e < 4; ++e) { v0[e] *= f[e]; v1[e] *= f[4 + e]; }
                    if (seg < 2) { acc[ai][bj][m][0] = v0; acc[ai][bj][m][1] = v1; }
                    else { u32x4 w; w.x = pk_bf16(v0[0], v0[1]); w.y = pk_bf16(v0[2], v0[3]); w.z = pk_bf16(v1[0], v1[1]); w.w = pk_bf16(v1[2], v1[3]);
                        *(u32x4*)(out + off + bj * 128) = w; } } }
        }
    }
};
struct EpiWout {
    static constexpr bool PERM = false;
    const float* x; float* out; bf16_t* x1b; float* sumsq;
    DI bool keep(const Unit&) const { return false; }
    DI void operator()(Acc& acc, const Unit& u, int wr, int wc, int fr, int fq) const {
        const int row0 = u.pm * 256 + wr * 64 + fr, col0 = u.pn * 256 + wc * 32 + 4 * fq;
#pragma unroll
        for (int ai = 0; ai < 2; ++ai) {
            f32x4 xv[4][2][2];
#pragma unroll
            for (int m = 0; m < 4; ++m)
#pragma unroll
                for (int bj = 0; bj < 2; ++bj)
#pragma unroll
                    for (int n = 0; n < 2; ++n) xv[m][bj][n] = __builtin_nontemporal_load((const f32x4*)(x + (size_t)(row0 + ai * 128 + m * 16) * 2048 + col0 + bj * 128 + n * 16));
#pragma unroll
            for (int m = 0; m < 4; ++m) { const int row = row0 + ai * 128 + m * 16; const size_t off = (size_t)row * 2048 + col0; float ss = 0.f;
#pragma unroll
                for (int bj = 0; bj < 2; ++bj)
#pragma unroll
                    for (int n = 0; n < 2; ++n) { const size_t o = off + bj * 128 + n * 16; const f32x4 v = xv[m][bj][n] + acc[ai][bj][m][n];
                        *(f32x4*)(out + o) = v; ss += (v[0] * v[0] + v[1] * v[1]) + (v[2] * v[2] + v[3] * v[3]);
                        u32x2 w; w.x = pk_bf16(v[0], v[1]); w.y = pk_bf16(v[2], v[3]); *(u32x2*)(x1b + o) = w; }
                ss += __shfl_xor(ss, 16); ss += __shfl_xor(ss, 32);
                if (fq == 0) atomicAdd(sumsq + row, ss); }
        }
    }
};
struct EpiGateUp {
    static constexpr bool PERM = true;
    const float* sumsq; bf16_t* hmid;
    DI bool keep(const Unit&) const { return false; }
    DI void operator()(Acc& acc, const Unit& u, int wr, int wc, int fr, int fq) const {
        const int row0 = u.pm * 256 + wr * 64 + fr, col0 = u.pn * 128 + wc * 32 + 8 * fq;
        float rsv[2][4];
#pragma unroll
        for (int ai = 0; ai < 2; ++ai)
#pragma unroll
            for (int m = 0; m < 4; ++m) rsv[ai][m] = sumsq[row0 + ai * 128 + m * 16];
#pragma unroll
        for (int ai = 0; ai < 2; ++ai)
#pragma unroll
            for (int m = 0; m < 4; ++m) { const int row = row0 + ai * 128 + m * 16; const float rs = frsq(rsv[ai][m] * (1.0f / 2048.0f) + EPS);
                float hv[8];
#pragma unroll
                for (int n = 0; n < 2; ++n)
#pragma unroll
                    for (int e = 0; e < 4; ++e) { const float gg = acc[ai][0][m][n][e] * rs, uu = acc[ai][1][m][n][e] * rs; hv[n * 4 + e] = gg * frcp(1.f + fexp2(-LOG2E * gg)) * uu; }
                u32x4 w; w.x = pk_bf16(hv[0], hv[1]); w.y = pk_bf16(hv[2], hv[3]); w.z = pk_bf16(hv[4], hv[5]); w.w = pk_bf16(hv[6], hv[7]);
                *(u32x4*)(hmid + (size_t)row * DFF + col0) = w; }
    }
};
struct EpiDown {
    static constexpr bool PERM = false;
    float* out;
    DI bool keep(const Unit&) const { return false; }
    DI void operator()(Acc& acc, const Unit& u, int wr, int wc, int fr, int fq) const {
        const int row0 = u.pm * 256 + wr * 64 + fr, col0 = u.pn * 256 + wc * 32 + 4 * fq;
#pragma unroll
        for (int ai = 0; ai < 2; ++ai) {
            f32x4 xv[4][2][2];
#pragma unroll
            for (int m = 0; m < 4; ++m)
#pragma unroll
                for (int bj = 0; bj < 2; ++bj)
#pragma unroll
                    for (int n = 0; n < 2; ++n) xv[m][bj][n] = __builtin_nontemporal_load((const f32x4*)(out + (size_t)(row0 + ai * 128 + m * 16) * 2048 + col0 + bj * 128 + n * 16));
#pragma unroll
            for (int m = 0; m < 4; ++m)
#pragma unroll
                for (int bj = 0; bj < 2; ++bj)
#pragma unroll
                    for (int n = 0; n < 2; ++n) __builtin_nontemporal_store(xv[m][bj][n] + acc[ai][bj][m][n], (f32x4*)(out + (size_t)(row0 + ai * 128 + m * 16) * 2048 + col0 + bj * 128 + n * 16));
        }
    }
};

struct Params { const float* in[25]; float* out; unsigned char* ws; int ph_lo, ph_hi; };
enum { I_X = 0, I_MEM, I_POS, I_ANG, I_WIN, I_DQG, I_DKG, I_LQ1, I_LK1, I_LQ2, I_LK2, I_SUBLN, I_RNG, I_MNG, I_WKV, I_MQG, I_MKG, I_WODA, I_WORET, I_WOMEM, I_WOUT, I_FNG, I_WG, I_WU, I_WD };

DI float wave_sum(float v) {
#pragma unroll
    for (int o = 1; o < 64; o <<= 1) v += __shfl_xor(v, o);
    return v;
}

DI void transpose_item(const float* W, int K, int N, const float* g, bf16_t* WT, int rstride, int roff, LAS float* scr, int item, int lane, bool qkperm = false) {
    const int nblk = N / 32, kb = item / nblk, nb = item % nblk, k0 = 64 * kb, n0 = 32 * nb;
    float wv[32];
#pragma unroll
    for (int i = 0; i < 32; ++i) { const int kk = 2 * i + (lane >> 5); wv[i] = __builtin_nontemporal_load(W + (size_t)(k0 + kk) * N + n0 + (lane & 31));   }
    if (g) {
#pragma unroll
        for (int i = 0; i < 32; ++i) wv[i] *= g[k0 + 2 * i + (lane >> 5)];
    }
#pragma unroll
    for (int i = 0; i < 32; ++i) { const int kk = 2 * i + (lane >> 5); scr[kk * 33 + (lane & 31)] = wv[i]; }
    asm volatile("s_waitcnt lgkmcnt(0)" ::: "memory");
    const int c = lane & 7;
#pragma unroll
    for (int j = 0; j < 4; ++j) { const int n = (lane >> 3) + 8 * j; const LAS float* s = scr + (8 * c) * 33 + n;
        u32x4 o; o.x = pk_bf16(s[0 * 33], s[1 * 33]); o.y = pk_bf16(s[2 * 33], s[3 * 33]); o.z = pk_bf16(s[4 * 33], s[5 * 33]); o.w = pk_bf16(s[6 * 33], s[7 * 33]);
        const int ng = n0 + n; int drow = (ng >> 7) * rstride + (ng & 127) + roff;
        if (qkperm && (ng < 2048 || (ng >= 3072 && ng < 4096))) drow = (ng & ~255) + 128 * ((ng >> 5) & 1) + 32 * ((ng >> 6) & 3) + (ng & 31);
        *(u32x4*)(WT + (size_t)drow * K + k0 + 8 * c) = o; }
    asm volatile("s_waitcnt lgkmcnt(0)" ::: "memory");
}
DI void row_to_bf16(const float* xrow, bf16_t* orow, float* rstd_out, int lane) {
    const f32x4* xr = (const f32x4*)xrow + lane; f32x4 v[8]; float s = 0.f;
#pragma unroll
    for (int j = 0; j < 8; ++j) { v[j] = __builtin_nontemporal_load(xr + 64 * j); s += (v[j][0] * v[j][0] + v[j][1] * v[j][1]) + (v[j][2] * v[j][2] + v[j][3] * v[j][3]); }
    s = wave_sum(s);
    if (lane == 0) *rstd_out = 1.0f / sqrtf(s * (1.0f / 2048.0f) + EPS);
    u32x2* o8 = (u32x2*)orow + lane;
#pragma unroll
    for (int j = 0; j < 8; ++j) { u32x2 w; w.x = pk_bf16(v[j][0], v[j][1]); w.y = pk_bf16(v[j][2], v[j][3]); o8[64 * j] = w; }
}
DI void tile_transpose64(const bf16_t* src, int lds_, bf16_t* dst, int ldd, int r0, int c0, int dr0, int dc0, LAS bf16_t* T, int tid) {
    { const int r = tid >> 3, ch = tid & 7; const u32x4 v = *(const u32x4*)(src + (size_t)(r0 + r) * lds_ + c0 + ch * 8);
      LAS bf16_t* t = T + (ch * 8) * 72 + r;
      t[0 * 72] = (bf16_t)(v.x & 0xffff); t[1 * 72] = (bf16_t)(v.x >> 16); t[2 * 72] = (bf16_t)(v.y & 0xffff); t[3 * 72] = (bf16_t)(v.y >> 16);
      t[4 * 72] = (bf16_t)(v.z & 0xffff); t[5 * 72] = (bf16_t)(v.z >> 16); t[6 * 72] = (bf16_t)(v.w & 0xffff); t[7 * 72] = (bf16_t)(v.w >> 16); }
    __syncthreads();
    { const int c = tid >> 3, ch = tid & 7; const u32x4 v = *(const LAS u32x4*)(T + c * 72 + ch * 8);
      *(u32x4*)(dst + (size_t)(dr0 + c) * ldd + dc0 + ch * 8) = v; }
    __syncthreads();
}

DI int lane_id() { return (int)__builtin_amdgcn_mbcnt_hi(~0u, __builtin_amdgcn_mbcnt_lo(~0u, 0u)); }
DI int pi32(int r) { return (r & ~12) | ((r & 4) << 1) | ((r & 8) >> 1); }

template <bool MASK>
DI void da_tile(const LAS unsigned char* Kb, const LAS unsigned char* Vb, const LAS unsigned char* Qb, f32x16 (&o1)[4], f32x16 (&o2)[4], float& l1, float& l2, int qrel, int khmax) {
#pragma unroll
    for (int kh = 0; kh < 2; ++kh) {
        if (!MASK || kh <= khmax) {
        bf16x8 pf1[2], pf2[2];
#pragma unroll
        for (int m = 0; m < 2; ++m) {
            f32x16 sv = f32x16{};
#pragma unroll
            for (int kp = 0; kp < 2; ++kp) {
                bf16x8 kf[2], qf[2];
#pragma unroll
                for (int k2 = 0; k2 < 2; ++k2) { const int ks = 2 * kp + k2; kf[k2] = *(const LAS bf16x8*)(Kb + (8 * m + 2 * ks) * 1024 + kh * 512); qf[k2] = *(const LAS bf16x8*)(Qb + (8 * m + 2 * ks) * 512); }
#pragma unroll
                for (int k2 = 0; k2 < 2; ++k2) sv = MFMA32(kf[k2], qf[k2], sv);
            }
            __builtin_amdgcn_sched_barrier(0);
            float ls = 0.f;
#pragma unroll
            for (int i = 0; i < 16; ++i) { float pv = fexp2(sv[i]);
                if (MASK) { const int key = 32 * kh + 16 * (i >> 3) + (i & 7); pv = (key > qrel) ? 0.f : pv; }
                sv[i] = pv; ls += pv; }
            if (m == 0) l1 += ls; else l2 += ls;
#pragma unroll
            for (int sx = 0; sx < 2; ++sx) { u32x4 w;
                w.x = pk_bf16(sv[8 * sx + 0], sv[8 * sx + 1]); w.y = pk_bf16(sv[8 * sx + 2], sv[8 * sx + 3]); w.z = pk_bf16(sv[8 * sx + 4], sv[8 * sx + 5]); w.w = pk_bf16(sv[8 * sx + 6], sv[8 * sx + 7]);
                if (m == 0) pf1[sx] = __builtin_bit_cast(bf16x8, w); else pf2[sx] = __builtin_bit_cast(bf16x8, w); }
        }
#pragma unroll
        for (int dp = 0; dp < 2; ++dp) {
            bf16x8 vf[2][2];
#pragma unroll
            for (int d2 = 0; d2 < 2; ++d2)
#pragma unroll
                for (int sx = 0; sx < 2; ++sx) vf[d2][sx] = *(const LAS bf16x8*)(Vb + (4 * kh + 2 * sx) * 2048 + (2 * dp + d2) * 512);
#pragma unroll
            for (int d2 = 0; d2 < 2; ++d2)
#pragma unroll
                for (int sx = 0; sx < 2; ++sx) { o1[2 * dp + d2] = MFMA32(vf[d2][sx], pf1[sx], o1[2 * dp + d2]); o2[2 * dp + d2] = MFMA32(vf[d2][sx], pf2[sx], o2[2 * dp + d2]); }
            __builtin_amdgcn_sched_barrier(0);
        }
        }
    }
}

DI void da_unit(LAS unsigned char* lds, bf16_t* projng, const bf16_t* kimg, const bf16_t* vimg, const float* subln, int head, int qb, float lam) {
    const int tid = threadIdx.x, lane = lane_id(), r = lane & 31, h = lane >> 5; const int wid = __builtin_amdgcn_readfirstlane(tid >> 6);
    const int qw = qb * 256 + wid * 32, NT = 4 * (qb + 1);
    f32x16 o1[4], o2[4];
#pragma unroll
    for (int d = 0; d < 4; ++d) { o1[d] = f32x16{}; o2[d] = f32x16{}; }
    float l1 = 0.f, l2 = 0.f;
    const bf16_t* ksrc = kimg + (size_t)head * 256 * 8192 + (2 * wid) * 512 + lane * 8;
    const bf16_t* vsrc = vimg + (size_t)head * 256 * 8192 + wid * 1024 + lane * 8;
    LAS unsigned char* kdst = lds + (2 * wid) * 1024; LAS unsigned char* vdst = lds + 32768 + wid * 2048;
#define DA_DMA(t, buf) do { \
        __builtin_amdgcn_global_load_lds((const unsigned*)(ksrc + (size_t)(t) * 8192), (LAS unsigned*)(kdst + (buf) * 16384), 16, 0, 0); \
        __builtin_amdgcn_global_load_lds((const unsigned*)(ksrc + (size_t)(t) * 8192 + 512), (LAS unsigned*)(kdst + (buf) * 16384 + 1024), 16, 0, 0); \
        __builtin_amdgcn_global_load_lds((const unsigned*)(vsrc + (size_t)(t) * 8192), (LAS unsigned*)(vdst + (buf) * 16384), 16, 0, 0); \
        __builtin_amdgcn_global_load_lds((const unsigned*)(vsrc + (size_t)(t) * 8192 + 512), (LAS unsigned*)(vdst + (buf) * 16384 + 1024), 16, 0, 0); } while (0)
    { const bf16_t* qsrc = projng + (size_t)(qw + r) * NG + C_DAQ + head * 128 + h * 8; LAS unsigned char* qdst = lds + 65536 + wid * 8192;
#pragma unroll
      for (int j = 0; j < 8; ++j) __builtin_amdgcn_global_load_lds((const unsigned*)(qsrc + j * 16), (LAS unsigned*)(qdst + j * 1024), 16, 0, 0); }
    const int kbase = h * 1024 + pi32(r) * 16;
    const int vbase = h * 2048 + r * 16;
    const LAS unsigned char* Qb = lds + 65536 + wid * 8192 + h * 512 + r * 16;
    DA_DMA(0, 0);
    __syncthreads();
    const int n_full = (qw + 1) >> 6;
    for (int t = 0; t < n_full; ++t) {
        const int buf = t & 1;
        DA_DMA(t + 1, buf ^ 1);
        da_tile<false>(lds + buf * 16384 + kbase, lds + 32768 + buf * 16384 + vbase, Qb, o1, o2, l1, l2, 0, 1);
        __syncthreads();
    }
    for (int t = n_full; t < NT; ++t) {
        const int buf = t & 1;
        if (t + 1 < NT) DA_DMA(t + 1, buf ^ 1);
        if (64 * t <= qw + 31) da_tile<true>(lds + buf * 16384 + kbase, lds + 32768 + buf * 16384 + vbase, Qb, o1, o2, l1, l2, qw + r - 64 * t - 8 * h, (64 * t + 32 > qw + 31) ? 0 : 1);
        __syncthreads();
    }
#undef DA_DMA
    l1 += __shfl_xor(l1, 32); l2 += __shfl_xor(l2, 32);
    const float i1 = 1.0f / l1, i2 = lam / l2; float ss = 0.f;
#pragma unroll
    for (int db = 0; db < 4; ++db)
#pragma unroll
        for (int i = 0; i < 16; ++i) { const float v = o1[db][i] * i1 - o2[db][i] * i2; o1[db][i] = v; ss += v * v; }
    ss += __shfl_xor(ss, 32);
    const float rs = 0.8f / sqrtf(ss * (1.0f / 128.0f) + EPS);
    bf16_t* orow = projng + (size_t)(qw + r) * NG + C_DAV + head * 128 + 4 * h;
#pragma unroll
    for (int db = 0; db < 4; ++db)
#pragma unroll
        for (int g4 = 0; g4 < 4; ++g4) { const int dv = 32 * db + 8 * g4; const f32x4 gv = *(const f32x4*)(subln + dv + 4 * h);
            u32x2 w; w.x = pk_bf16(o1[db][4 * g4 + 0] * rs * gv[0], o1[db][4 * g4 + 1] * rs * gv[1]); w.y = pk_bf16(o1[db][4 * g4 + 2] * rs * gv[2], o1[db][4 * g4 + 3] * rs * gv[3]);
            *(u32x2*)(orow + dv) = w; }
}

DI void ret_load_vt(LAS bf16_t* VTs, const bf16_t* projng, int pos0, int hd, int tid) {
#pragma unroll
    for (int i = 0; i < 4; ++i) { const int id = tid + 512 * i, pos = id >> 4, ch = id & 15;
        const u32x4 v = *(const u32x4*)(projng + (size_t)(pos0 + pos) * NG + C_RV + hd * 128 + ch * 8);
        LAS bf16_t* t = VTs + (ch * 8) * 136 + pos;
        t[0 * 136] = (bf16_t)(v.x & 0xffff); t[1 * 136] = (bf16_t)(v.x >> 16); t[2 * 136] = (bf16_t)(v.y & 0xffff); t[3 * 136] = (bf16_t)(v.y >> 16);
        t[4 * 136] = (bf16_t)(v.z & 0xffff); t[5 * 136] = (bf16_t)(v.z >> 16); t[6 * 136] = (bf16_t)(v.w & 0xffff); t[7 * 136] = (bf16_t)(v.w >> 16); }
}
DI void ret_r1_unit(LAS unsigned char* lds, const bf16_t* projng, float* retU, int c, int hd) {
    const int tid = threadIdx.x, lane = lane_id(), r = lane & 31, h = lane >> 5; const int wid = __builtin_amdgcn_readfirstlane(tid >> 6);
    LAS bf16_t* VTs = (LAS bf16_t*)lds; LAS bf16_t* KTs = (LAS bf16_t*)(lds + 128 * 272);
    const int pos0 = c * 128; const float lg = log2f(1.0f - exp2f(-5.0f - (float)hd));
    ret_load_vt(VTs, projng, pos0, hd, tid);
#pragma unroll
    for (int i = 0; i < 2; ++i) { const int id = tid + 512 * i, pos = id >> 3, ch = id & 7;
        const u32x4 v = *(const u32x4*)(projng + (size_t)(pos0 + pos) * NG + C_RK + hd * 64 + ch * 8);
        const float kd = fexp2(lg * (float)(127 - pos));
        LAS bf16_t* t = KTs + (ch * 8) * 136 + pos;
        t[0 * 136] = (bf16_t)(pk_bf16(bf_lo(v.x) * kd, 0.f) & 0xffff); t[1 * 136] = (bf16_t)(pk_bf16(bf_hi(v.x) * kd, 0.f) & 0xffff);
        t[2 * 136] = (bf16_t)(pk_bf16(bf_lo(v.y) * kd, 0.f) & 0xffff); t[3 * 136] = (bf16_t)(pk_bf16(bf_hi(v.y) * kd, 0.f) & 0xffff);
        t[4 * 136] = (bf16_t)(pk_bf16(bf_lo(v.z) * kd, 0.f) & 0xffff); t[5 * 136] = (bf16_t)(pk_bf16(bf_hi(v.z) * kd, 0.f) & 0xffff);
        t[6 * 136] = (bf16_t)(pk_bf16(bf_lo(v.w) * kd, 0.f) & 0xffff); t[7 * 136] = (bf16_t)(pk_bf16(bf_hi(v.w) * kd, 0.f) & 0xffff); }
    __syncthreads();
    const int db = wid >> 1, nb = wid & 1; f32x16 acc = f32x16{};
#pragma unroll
    for (int ks = 0; ks < 8; ++ks) { const bf16x8 a = *(const LAS bf16x8*)(VTs + (32 * db + r) * 136 + 16 * ks + 8 * h); const bf16x8 b = *(const LAS bf16x8*)(KTs + (32 * nb + r) * 136 + 16 * ks + 8 * h);
        acc = MFMA32(a, b, acc); }
    float* up = retU + ((size_t)(c * 8 + hd) * 128 + 32 * db + 4 * h) * 64 + 32 * nb + r;
#pragma unroll
    for (int i = 0; i < 16; ++i) up[((i & 3) + 8 * (i >> 2)) * 64] = acc[i];
    __syncthreads();
}
DI void ret_r3_unit(LAS unsigned char* lds, bf16_t* projng, const bf16_t* states, const float* norm_g, int c, int hd) {
    const int tid = threadIdx.x, lane = lane_id(), r = lane & 31, h = lane >> 5; const int wid = __builtin_amdgcn_readfirstlane(tid >> 6);
    LAS bf16_t* VTs = (LAS bf16_t*)lds; LAS bf16_t* Ks = (LAS bf16_t*)(lds + 128 * 272); LAS float* red = (LAS float*)(lds + 128 * 272 + 128 * 144);
    const int pos0 = c * 128; const float lg = log2f(1.0f - exp2f(-5.0f - (float)hd));
    ret_load_vt(VTs, projng, pos0, hd, tid);
#pragma unroll
    for (int i = 0; i < 2; ++i) { const int id = tid + 512 * i, pos = id >> 3, ch = id & 7;
        const u32x4 v = *(const u32x4*)(projng + (size_t)(pos0 + pos) * NG + C_RK + hd * 64 + ch * 8);
        *(LAS u32x4*)(Ks + pos * 72 + ch * 8) = v; }
    const int qb = wid & 3, dh = wid >> 2, n = 32 * qb + r;
    bf16x8 qf[4];
    { const bf16_t* qrow = projng + (size_t)(pos0 + n) * NG + C_RQ + hd * 64 + 8 * h;
#pragma unroll
      for (int ks = 0; ks < 4; ++ks) qf[ks] = *(const bf16x8*)(qrow + 16 * ks); }
    f32x16 o[2];
    { const float qd = fexp2(lg * (float)(n + 1));
#pragma unroll
      for (int d2 = 0; d2 < 2; ++d2) { o[d2] = f32x16{}; const bf16_t* sp = states + ((size_t)(c * 8 + hd) * 128 + 32 * (2 * dh + d2) + r) * 64 + 8 * h;
#pragma unroll
          for (int ks = 0; ks < 4; ++ks) { const bf16x8 a = *(const bf16x8*)(sp + 16 * ks); o[d2] = MFMA32(a, qf[ks], o[d2]); }
#pragma unroll
          for (int i = 0; i < 16; ++i) o[d2][i] *= qd; } }
    __syncthreads();
    const int pr = pi32(r);
    for (int kb = 0; kb <= qb; ++kb) {
        f32x16 s = f32x16{};
#pragma unroll
        for (int ks = 0; ks < 4; ++ks) { const bf16x8 a = *(const LAS bf16x8*)(Ks + (32 * kb + pr) * 72 + 16 * ks + 8 * h); s = MFMA32(a, qf[ks], s); }
        bf16x8 pf[2];
#pragma unroll
        for (int i = 0; i < 16; ++i) { const int mk = 32 * kb + 16 * (i >> 3) + 8 * h + (i & 7); const int dlt = n - mk; s[i] = (dlt >= 0) ? s[i] * fexp2(lg * (float)dlt) : 0.f; }
#pragma unroll
        for (int sx = 0; sx < 2; ++sx) { u32x4 w; w.x = pk_bf16(s[8 * sx + 0], s[8 * sx + 1]); w.y = pk_bf16(s[8 * sx + 2], s[8 * sx + 3]); w.z = pk_bf16(s[8 * sx + 4], s[8 * sx + 5]); w.w = pk_bf16(s[8 * sx + 6], s[8 * sx + 7]);
            pf[sx] = __builtin_bit_cast(bf16x8, w); }
#pragma unroll
        for (int d2 = 0; d2 < 2; ++d2)
#pragma unroll
            for (int sx = 0; sx < 2; ++sx) { const bf16x8 a = *(const LAS bf16x8*)(VTs + (32 * (2 * dh + d2) + r) * 136 + 32 * kb + 16 * sx + 8 * h); o[d2] = MFMA32(a, pf[sx], o[d2]); }
    }
    float ss = 0.f;
#pragma unroll
    for (int d2 = 0; d2 < 2; ++d2)
#pragma unroll
        for (int i = 0; i < 16; ++i) ss += o[d2][i] * o[d2][i];
    ss += __shfl_xor(ss, 32);
    if (h == 0) red[wid * 32 + r] = ss;
    __syncthreads();
    const float tot = red[wid * 32 + r] + red[(wid ^ 4) * 32 + r];
    const float rs = 1.0f / sqrtf(tot * (1.0f / 128.0f) + EPS);
    bf16_t* grow = projng + (size_t)(pos0 + n) * NG + C_RG + hd * 128 + 4 * h;
#pragma unroll
    for (int d2 = 0; d2 < 2; ++d2)
#pragma unroll
        for (int g4 = 0; g4 < 4; ++g4) { const int dv = 32 * (2 * dh + d2) + 8 * g4; const f32x4 gv = *(const f32x4*)(norm_g + dv + 4 * h); const u32x2 gt = *(const u32x2*)(grow + dv);
            float ga[4] = {bf_lo(gt.x), bf_hi(gt.x), bf_lo(gt.y), bf_hi(gt.y)}; float y[4];
#pragma unroll
            for (int e = 0; e < 4; ++e) { const float sl = ga[e] * frcp(1.f + fexp2(-LOG2E * ga[e])); y[e] = o[d2][4 * g4 + e] * rs * gv[e] * sl; }
            u32x2 w; w.x = pk_bf16(y[0], y[1]); w.y = pk_bf16(y[2], y[3]); *(u32x2*)(grow + dv) = w; }
    __syncthreads();
}

#define XB_XCNT(j) (64 * (j))
#define XB_XSUB(j) (1024 + 64 * (j))
#define XB_XGEN(j) (2048 + 64 * (j))
#define XB_TOP 3072
#define XB_TOPGEN 3136
#define XB_WORDS 3200
DI unsigned xb_ld(unsigned* p) { return __hip_atomic_load(p, __ATOMIC_RELAXED, __HIP_MEMORY_SCOPE_AGENT); }
DI unsigned xb_add(unsigned* p, unsigned v) { return __hip_atomic_fetch_add(p, v, __ATOMIC_RELAXED, __HIP_MEMORY_SCOPE_AGENT); }
DI unsigned xb_xcc_id() { return (unsigned)__builtin_amdgcn_s_getreg((3 << 11) | 20) & 0xFu; }
DI void grid_bar(unsigned* bar, unsigned G, volatile LAS unsigned* st) {
    asm volatile("s_waitcnt vmcnt(0) lgkmcnt(0)" ::: "memory");
    __syncthreads();
    if (threadIdx.x == 0) {
        const unsigned x = xb_xcc_id();
        unsigned nloc = st[0], nx = st[1];
        if (nloc == 0u) {
            for (;;) { unsigned sum = 0u, cnt = 0u, mine = 0u;
#pragma unroll
                for (unsigned j = 0; j < 16; ++j) { const unsigned c = xb_ld(&bar[XB_XCNT(j)]); sum += c; cnt += (c > 0u) ? 1u : 0u; mine = (j == x) ? c : mine; }
                if (sum == G) { nloc = mine; nx = cnt; break; }
                __builtin_amdgcn_s_sleep(2); }
            st[0] = nloc; st[1] = nx; }
        const unsigned old = xb_add(&bar[XB_XSUB(x)], 1u);
        const unsigned gen = old / nloc;
        if (old + 1u == (gen + 1u) * nloc) {
            __builtin_amdgcn_fence(__ATOMIC_RELEASE, "agent");
            asm volatile("s_waitcnt vmcnt(0)" ::: "memory");
            const unsigned og = xb_add(&bar[XB_TOP], 1u);
            const unsigned tg = og / nx;
            if (og + 1u == (tg + 1u) * nx) xb_add(&bar[XB_TOPGEN], 1u);
            else while (xb_ld(&bar[XB_TOPGEN]) == tg) __builtin_amdgcn_s_sleep(1);
            __builtin_amdgcn_fence(__ATOMIC_ACQUIRE, "agent");
            xb_add(&bar[XB_XGEN(x)], 1u);
            asm volatile("s_waitcnt vmcnt(0)" ::: "memory");
        } else {
            while (xb_ld(&bar[XB_XGEN(x)]) == gen) __builtin_amdgcn_s_sleep(1);
            __builtin_amdgcn_fence(__ATOMIC_ACQUIRE, "agent");
            asm volatile("s_waitcnt vmcnt(0)" ::: "memory");
        }
    }
    __syncthreads();
}

constexpr int LDS_BYTES = 147456;
__global__ void __launch_bounds__(512, 2) mega(Params p) {
    extern __shared__ __attribute__((aligned(16))) unsigned char lds_raw[];
    LAS unsigned char* lds = (LAS unsigned char*)lds_raw;
    cg::grid_group grid = cg::this_grid();
    const int tid = threadIdx.x, lane = tid & 63; const int wave = __builtin_amdgcn_readfirstlane(tid >> 6);
    const int G = gridDim.x, bid = blockIdx.x;
    const int gw = bid * 8 + wave, NGW = G * 8;
    unsigned char* ws = p.ws;
    bf16_t* projng = (bf16_t*)(ws + WS_PROJ);
    bf16_t* gda = (bf16_t*)p.out; bf16_t* gret = (bf16_t*)((unsigned char*)p.out + 64 * MiB); bf16_t* gmem = (bf16_t*)(ws + WS_GMEM);
    bf16_t* xb = (bf16_t*)(ws + WS_XB);
    bf16_t* win_t = (bf16_t*)(ws + WS_WIN); bf16_t* wkv_t = (bf16_t*)(ws + WS_WKV);
    bf16_t* woda_t = (bf16_t*)(ws + WS_WODA); bf16_t* woret_t = (bf16_t*)(ws + WS_WORET); bf16_t* womem_t = (bf16_t*)(ws + WS_WOMEM); bf16_t* wout_t = (bf16_t*)(ws + WS_WOUT);
    bf16_t* wgu_t = (bf16_t*)(ws + WS_WGU); bf16_t* wdn_t = (bf16_t*)(ws + WS_WDN);
    float* rcos = (float*)(ws + M_RCOS); float* rsin = (float*)(ws + M_RSIN); float* dcos = (float*)(ws + M_DCOS); float* dsin = (float*)(ws + M_DSIN);
    float* rstdx = (float*)(ws + M_RSTDX); float* sumsq = (float*)(ws + M_SUMSQ); float* rq = (float*)(ws + M_RQ); float* lmem = (float*)(ws + M_LMEM); float* rstdm = (float*)(ws + M_RSTDM);
    bf16_t* memb = (bf16_t*)(ws + M_MEMB); bf16_t* kvm = (bf16_t*)(ws + M_KVM); bf16_t* vtm = (bf16_t*)(ws + M_VTM);
    float* retU = (float*)(ws + WS_RETU); bf16_t* states = (bf16_t*)(ws + WS_STATES); bf16_t* kimg = (bf16_t*)(ws + 192 * MiB);     bf16_t* vimg = (bf16_t*)(ws + WS_VT);
    bf16_t* merged = (bf16_t*)(ws + WS_MERGED); bf16_t* x1b = (bf16_t*)(ws + WS_X1B); bf16_t* hmid = (bf16_t*)(ws + WS_HMID);
    unsigned* barw = (unsigned*)(ws + M_BAR);
    volatile LAS unsigned* bst = (volatile LAS unsigned*)(lds + 131072 + 256);
    if (tid == 0) { bst[0] = 0u; bst[1] = 0u; }
    __syncthreads();
    const int lo = p.ph_lo, hi = p.ph_hi;
#ifndef PHASE_MASK
#define PHASE_MASK 0x3ff
#endif
#define IN(k) (((PHASE_MASK >> (k)) & 1) && lo <= (k) && (k) < hi)
#define SEAM(k) do { if (IN(k) && IN((k) + 1)) { if ((k) == 0) grid.sync(); else grid_bar(barw, (unsigned)G, bst); } } while (0)

    if (IN(0)) {
        LAS float* scr = (LAS float*)(lds + wave * 16384);
        const int I_WIN_N = 32 * (NCOL / 32), I_KV_N = 32 * 64, I_O_N = 16 * 64, I_OUT_N = 32 * 64, I_G_N = 32 * (DFF / 32), I_D_N = (DFF / 64) * 64;
        const int NITEMS = I_WIN_N + I_KV_N + 3 * I_O_N + I_OUT_N + 2 * I_G_N + I_D_N;
        for (int it = gw; it < NITEMS * DUP_P0; it += NGW) {
            int r = it % NITEMS;
            if (r < I_WIN_N) { transpose_item(p.in[I_WIN], DM, NCOL, p.in[I_ANG], win_t, 128, 0, scr, r, lane, true); continue; } r -= I_WIN_N;
            if (r < I_KV_N) { transpose_item(p.in[I_WKV], DM, 2048, p.in[I_MNG], wkv_t, 128, 0, scr, r, lane); continue; } r -= I_KV_N;
            if (r < I_O_N) { transpose_item(p.in[I_WODA], 1024, DM, nullptr, woda_t, 128, 0, scr, r, lane); continue; } r -= I_O_N;
            if (r < I_O_N) { transpose_item(p.in[I_WORET], 1024, DM, nullptr, woret_t, 128, 0, scr, r, lane); continue; } r -= I_O_N;
            if (r < I_O_N) { transpose_item(p.in[I_WOMEM], 1024, DM, nullptr, womem_t, 128, 0, scr, r, lane); continue; } r -= I_O_N;
            if (r < I_OUT_N) { transpose_item(p.in[I_WOUT], DM, DM, nullptr, wout_t, 128, 0, scr, r, lane); continue; } r -= I_OUT_N;
            if (r < I_G_N) { transpose_item(p.in[I_WG], DM, DFF, p.in[I_FNG], wgu_t, 256, 0, scr, r, lane); continue; } r -= I_G_N;
            if (r < I_G_N) { transpose_item(p.in[I_WU], DM, DFF, p.in[I_FNG], wgu_t, 256, 128, scr, r, lane); continue; } r -= I_G_N;
            transpose_item(p.in[I_WD], DFF, DM, nullptr, wdn_t, 128, 0, scr, r, lane);
        }
        for (int m = gw; m < SEQ; m += NGW) row_to_bf16(p.in[I_X] + (size_t)m * DM, xb + (size_t)m * DM, rstdx + m, lane);
        for (int m = gw; m < NMEM; m += NGW) row_to_bf16(p.in[I_MEM] + (size_t)m * DM, memb + (size_t)m * DM, rstdm + m, lane);
        const int* posi = (const int*)p.in[I_POS];
        for (int i = bid * 512 + tid; i < SEQ * 40; i += G * 512) {
            const int row = i / 40, j = i - row * 40; const double pos = (double)posi[row];
            double inv; if (j < 32) inv = exp(-((double)j / 32.0) * 9.210340371976184); else inv = exp(-((double)(j - 32) / 8.0) * 13.122363377404328);
            const double turns = pos * inv * 0.15915494309189535; const float fr_ = (float)(turns - rint(turns));
            const float cs = __builtin_amdgcn_cosf(fr_), sn = __builtin_amdgcn_sinf(fr_);
            if (j < 32) { rcos[row * 32 + j] = cs; rsin[row * 32 + j] = sn; } else { dcos[row * 8 + j - 32] = cs; dsin[row * 8 + j - 32] = sn; }
        }
        if (bid == 0) for (int i = tid; i < XB_WORDS; i += 512) barw[i] = 0u;
        for (int i = bid * 512 + tid; i < SEQ; i += G * 512) sumsq[i] = 0.f;
        for (int i = bid * 512 + tid; i < SEQ * 4; i += G * 512) { lmem[i] = 0.f; rq[i] = 0.f; }
    }
    SEAM(0);
    if (IN(1)) {
        if (tid == 0) (void)xb_add(&barw[XB_XCNT(xb_xcc_id())], 1u);
        { pg8::TileSched S; S.init(SEQ / 256, NCOL / 256, 1, G, bid, DUP_P1); S.A = (const char*)xb; S.B = (const char*)win_t; S.a_tile_bytes = (size_t)256 * DM * 2; S.a_pn_bytes = 0; S.b_seg_bytes = 0; S.b_tile_bytes = (size_t)256 * DM * 2;
          EpiInProj E{ws, (long)((char*)p.out - (char*)projng), p.in[I_DQG], p.in[I_DKG]};
          pg8::gemm_phase<EpiInProj, pg8::TileSched>(lds, DM, DM, DM, S, E); }
    }
    SEAM(1);
    if (IN(2)) {
        const bool kvblk = (G > 16) && (bid < 8);
        const int eb = (G > 16) ? bid - 8 : bid, EG = (G > 16) ? G - 8 : G;
        if (kvblk || G <= 16) {
          pg8::TileSched S; S.init(1, 8, 1, (G > 16) ? 8 : G, bid); S.A = (const char*)memb; S.B = (const char*)wkv_t; S.a_tile_bytes = (size_t)256 * DM * 2; S.a_pn_bytes = 0; S.b_seg_bytes = 0; S.b_tile_bytes = (size_t)256 * DM * 2;
          EpiRowScale E{kvm, 0, rstdm, 1};
          pg8::gemm_phase<EpiRowScale, pg8::TileSched>(lds, DM, DM, DM, S, E); }
        if (!kvblk) {
        { LAS bf16_t* T = (LAS bf16_t*)lds;
          for (int t = eb; t < (SEQ / 64) * 16; t += EG) { const int rt = t >> 4, ct = t & 15;
              { const int r = tid >> 3, ch = tid & 7; const u32x4 v = *(const u32x4*)(projng + (size_t)(rt * 64 + r) * NG + C_DAV + ct * 64 + ch * 8);
                LAS bf16_t* tp = T + (ch * 8) * 72 + r;
                tp[0 * 72] = (bf16_t)(v.x & 0xffff); tp[1 * 72] = (bf16_t)(v.x >> 16); tp[2 * 72] = (bf16_t)(v.y & 0xffff); tp[3 * 72] = (bf16_t)(v.y >> 16);
                tp[4 * 72] = (bf16_t)(v.z & 0xffff); tp[5 * 72] = (bf16_t)(v.z >> 16); tp[6 * 72] = (bf16_t)(v.w & 0xffff); tp[7 * 72] = (bf16_t)(v.w >> 16); }
              __syncthreads();
              { const int c = tid >> 3, ch = tid & 7; const u32x4 v = *(const LAS u32x4*)(T + c * 72 + ch * 8); const int dvg = ct * 64 + c, hd = dvg >> 7, dvl = dvg & 127;
                *(u32x4*)(vimg + ((((size_t)(hd * 256 + rt) * 8 + ch) * 128 + dvl) * 8)) = v; }
              __syncthreads(); }
          }
        }
    }
    SEAM(2);
    if (IN(3)) {
        for (int repr = 0; repr < DUP_R; ++repr)
        for (int u = bid; u < 1024; u += G) ret_r1_unit(lds, projng, retU, u >> 3, u & 7);
        { const float* mqg = p.in[I_MQG]; const float* mkg = p.in[I_MKG];
          for (int row = gw; row < NMEM; row += NGW) {
#pragma unroll
              for (int it = 0; it < 2; ++it) { const int hd = it * 2 + (lane >> 5), sub = lane & 31; bf16_t* ptr = kvm + (size_t)row * 2048 + hd * 256 + sub * 8; const u32x4 raw = *(const u32x4*)ptr;
                  float v[8] = {bf_lo(raw.x), bf_hi(raw.x), bf_lo(raw.y), bf_hi(raw.y), bf_lo(raw.z), bf_hi(raw.z), bf_lo(raw.w), bf_hi(raw.w)}; float ss = 0.f;
#pragma unroll
                  for (int j = 0; j < 8; ++j) ss += v[j] * v[j];
                  ss += __shfl_xor(ss, 1); ss += __shfl_xor(ss, 2); ss += __shfl_xor(ss, 4); ss += __shfl_xor(ss, 8); ss += __shfl_xor(ss, 16);
                  const float rs = (0.0625f * LOG2E) / sqrtf(ss * (1.0f / 256.0f) + EPS);
#pragma unroll
                  for (int j = 0; j < 8; ++j) v[j] = v[j] * rs * mqg[sub * 8 + j] * mkg[sub * 8 + j];
                  u32x4 w; w.x = pk_bf16(v[0], v[1]); w.y = pk_bf16(v[2], v[3]); w.z = pk_bf16(v[4], v[5]); w.w = pk_bf16(v[6], v[7]); *(u32x4*)ptr = w; } } }
        { LAS bf16_t* T = (LAS bf16_t*)lds;
          for (int t = bid; t < 4 * 16; t += G) { const int rt = t >> 4, ct = t & 15; tile_transpose64(kvm, 2048, vtm, 256, rt * 64, 1024 + ct * 64, ct * 64, rt * 64, T, tid); } }
    }
    SEAM(3);
    if (IN(4)) {
        const int gid = bid * 512 + tid;
        for (int repr = 0; repr < DUP_R; ++repr)
        if (gid < 65536) { const int hd = gid >> 13, e = gid & 8191; const float cd = exp2f(128.0f * log2f(1.0f - exp2f(-5.0f - (float)hd))); float st = 0.f;
            const float* up = retU + (size_t)hd * 8192 + e; bf16_t* sp = states + (size_t)hd * 8192 + e;
#pragma unroll 8
            for (int c = 0; c < 128; ++c) { sp[(size_t)c * 65536] = (bf16_t)(pk_bf16(st, 0.f) & 0xffff); st = st * cd + up[(size_t)c * 65536]; } }
        { pg8::TileSched S; S.init(SEQ / 256, 4, 1, G, bid); S.A = (const char*)(projng + C_MQ); S.B = (const char*)kvm; S.a_tile_bytes = (size_t)256 * NG * 2; S.a_pn_bytes = 512; S.b_seg_bytes = 0; S.b_tile_bytes = 512;
          EpiMemS E{projng, rq, lmem};
          pg8::gemm_phase<EpiMemS, pg8::TileSched>(lds, NG, 2048, 256, S, E); }
        asm volatile("s_waitcnt vmcnt(0)" ::: "memory"); __syncthreads();
        { pg8::TileSched S; S.init(SEQ / 256, 4, 1, G, bid); S.A = (const char*)(projng + C_MQ); S.B = (const char*)vtm; S.a_tile_bytes = (size_t)256 * NG * 2; S.a_pn_bytes = 512; S.b_seg_bytes = 0; S.b_tile_bytes = (size_t)256 * 256 * 2;
          EpiMemO E{projng, lmem};
          pg8::gemm_phase<EpiMemO, pg8::TileSched>(lds, NG, 256, 256, S, E); }
    }
    SEAM(4);
    if (IN(5)) {
        for (int u = bid; u < 1024; u += G) ret_r3_unit(lds, projng, states, p.in[I_RNG], u >> 3, u & 7);
        float lam;
        { const int ln = (int)__builtin_amdgcn_mbcnt_hi(~0u, __builtin_amdgcn_mbcnt_lo(~0u, 0u));
          const float a = wave_sum(p.in[I_LQ1][ln] * p.in[I_LK1][ln]), b = wave_sum(p.in[I_LQ2][ln] * p.in[I_LK2][ln]); lam = expf(a) - expf(b) + 0.2f; }
#ifndef DUP_DA
#define DUP_DA 1
#endif
        for (int rep = 0; rep < DUP_DA; ++rep)
        for (int u = bid; u < 256; u += G) { const int head = u & 7, j = u >> 3;
            da_unit(lds, projng, kimg, vimg, p.in[I_SUBLN], head, 63 - j, lam);
            da_unit(lds, projng, kimg, vimg, p.in[I_SUBLN], head, j, lam); }
    }
    SEAM(5);
    if (IN(6)) {
        pg8::TileSched S; S.init(SEQ / 256, DM / 256, 3, G, bid, DUP_P6);
        S.A = (const char*)projng; S.B = (const char*)woda_t;
        S.a_tile_bytes = (size_t)256 * NG * 2; S.a_pn_bytes = 0; S.b_tile_bytes = (size_t)256 * 1024 * 2; S.b_seg_bytes = 4 * MiB;
        EpiMerge E{gda, (long)((char*)gmem - (char*)gda), merged};
        pg8::gemm_phase<EpiMerge, pg8::TileSched>(lds, NG, 1024, 1024, S, E);
    }
    SEAM(6);
    if (IN(7)) {
        pg8::TileSched S; S.init(SEQ / 256, DM / 256, 1, G, bid); S.A = (const char*)merged; S.B = (const char*)wout_t; S.a_tile_bytes = (size_t)256 * DM * 2; S.a_pn_bytes = 0; S.b_seg_bytes = 0; S.b_tile_bytes = (size_t)256 * DM * 2;
        EpiWout E{p.in[I_X], p.out, x1b, sumsq};
        pg8::gemm_phase<EpiWout, pg8::TileSched>(lds, DM, DM, DM, S, E);
    }
    SEAM(7);
    if (IN(8)) {
        pg8::TileSched S; S.init(SEQ / 256, 2 * DFF / 256, 1, G, bid, DUP_P8); S.A = (const char*)x1b; S.B = (const char*)wgu_t; S.a_tile_bytes = (size_t)256 * DM * 2; S.a_pn_bytes = 0; S.b_seg_bytes = 0; S.b_tile_bytes = (size_t)256 * DM * 2;
        EpiGateUp E{sumsq, hmid};
        pg8::gemm_phase<EpiGateUp, pg8::TileSched>(lds, DM, DM, DM, S, E);
    }
    SEAM(8);
    if (IN(9)) {
        pg8::TileSched S; S.init(SEQ / 256, DM / 256, 1, G, bid); S.A = (const char*)hmid; S.B = (const char*)wdn_t; S.a_tile_bytes = (size_t)256 * DFF * 2; S.a_pn_bytes = 0; S.b_seg_bytes = 0; S.b_tile_bytes = (size_t)256 * DFF * 2;
        EpiDown E{p.out};
        pg8::gemm_phase<EpiDown, pg8::TileSched>(lds, DFF, DFF, DFF, S, E);
    }
#undef IN
#undef SEAM
}

#ifndef N_LAUNCH_SPLIT
#define N_LAUNCH_SPLIT 0
#endif
extern "C" void kernel_launch(void* const* d_in, const int* in_sizes, int n_in, void* d_out, int out_size, void* d_ws, size_t ws_size, hipStream_t stream) {
    static int grid = 0;
    if (grid == 0) {
        if (n_in != 25 || ws_size < WS_END) { fprintf(stderr, "kernel_launch: unexpected n_in %d / ws_size %zu\n", n_in, ws_size); grid = -1; return; }
        int dev = 0, cus = 0, per_cu = 0;
        hipGetDevice(&dev); hipDeviceGetAttribute(&cus, hipDeviceAttributeMultiprocessorCount, dev);
        hipFuncSetAttribute((const void*)mega, hipFuncAttributeMaxDynamicSharedMemorySize, LDS_BYTES);
        if (hipOccupancyMaxActiveBlocksPerMultiprocessor(&per_cu, (const void*)mega, 512, LDS_BYTES) != hipSuccess || per_cu < 1) per_cu = 1;
        (void)hipGetLastError();
        grid = cus * 1;
        if (grid <= 0) grid = 256;
    }
    if (grid < 0) return;
    Params p{};
    for (int i = 0; i < 25; ++i) p.in[i] = (const float*)d_in[i];
    p.out = (float*)d_out; p.ws = (unsigned char*)d_ws;
    void* args[] = {&p};
#if N_LAUNCH_SPLIT
    for (int ph = 0; ph < 10; ++ph) { p.ph_lo = ph; p.ph_hi = ph + 1;
        hipError_t e = hipLaunchCooperativeKernel((const void*)mega, dim3(grid), dim3(512), args, LDS_BYTES, stream);
        if (e != hipSuccess) { fprintf(stderr, "cooperative launch failed: %s\n", hipGetErrorString(e)); break; } }
#else
    p.ph_lo = 0; p.ph_hi = 10;
    hipError_t e = hipLaunchCooperativeKernel((const void*)mega, dim3(grid), dim3(512), args, LDS_BYTES, stream);
    if (e != hipSuccess) fprintf(stderr, "cooperative launch failed: %s (grid %d)\n", hipGetErrorString(e), grid);
#endif
}
```
